# Optimizing an MI355X kernel written in HIP

```python
import math
import jax, jax.numpy as jnp
from jax import lax
import numpy as np

D_MODEL = 1024
BATCH = 8
SEQ = 2048
DEPTH = 2

GRID_W = 64
D_MIX = 256
N_BRANCH = 4
EPS = 1e-6
HY_ORDER = 2
HY_SHORT = 3
HY_BANDS = 16
HY_EMB = 2 * HY_BANDS + 1
HY_FFN = 64
HY_TARGET = 1e-2
HY_FAST_DECAY = 0.3
HY_SLOW_DECAY = 1.5
FN_GROUPS = 4
MLA_HEADS = 4
MLA_NOPE = 64
MLA_ROPE = 32
MLA_V = 64
MLA_Q_RANK = 256
MLA_KV_RANK = 128
ROPE_THETA = 10000.0
Q_BLOCK = 128
NA_HEADS = 4
NA_HEAD_DIM = D_MIX // NA_HEADS
NA_WIN_R = 8
NA_WIN_C = 16
N_EXPERTS = 16
EC_CAPACITY_FACTOR = 2
D_FF_EXPERT = 1024
PLE_DIM = 256

HY_COLS = 3 * D_MIX
FN_COLS = D_MIX
NA_COLS = 3 * D_MIX
GATE_COLS = N_BRANCH * D_MODEL
IN_SIZES = (HY_COLS, FN_COLS, MLA_Q_RANK, MLA_KV_RANK, MLA_ROPE, NA_COLS, GATE_COLS)
IN_COLS = sum(IN_SIZES)

kernel_name = "hybrid_hyena_fnet_mla_natten_ec_moe_encoder"


def rmsnorm(x, g):
    xf = x.astype(jnp.float32)
    y = xf * lax.rsqrt(jnp.mean(xf * xf, axis=-1, keepdims=True) + EPS)
    return (y * g.astype(jnp.float32)).astype(x.dtype)


def hyena_filters(L, w1, b1, freq, w2, b2, w3):
    f32 = jnp.float32
    t01 = jnp.linspace(0.0, 1.0, L, dtype=f32)[:, None]
    bands = jnp.linspace(1e-4, HY_BANDS - 1, HY_BANDS, dtype=f32)
    ang = 2.0 * math.pi * jnp.arange(L, dtype=f32)[:, None] * bands / L
    z = jnp.concatenate([t01, jnp.cos(ang), -jnp.sin(ang)], axis=-1)
    freq = freq.astype(f32)
    hf = jnp.sin(freq[0] * (z @ w1.astype(f32) + b1.astype(f32)))
    hf = jnp.sin(freq[1] * (hf @ w2.astype(f32) + b2.astype(f32)))
    hf = hf @ w3.astype(f32)
    max_decay = math.log(HY_TARGET) / HY_FAST_DECAY
    min_decay = math.log(HY_TARGET) / HY_SLOW_DECAY
    deltas = jnp.linspace(min_decay, max_decay, D_MIX, dtype=f32)
    window = jnp.exp(-t01 * jnp.abs(deltas))
    hf = hf.reshape(L, HY_ORDER, 2, D_MIX) * window[:, None, None, :]
    fwd, bwd = hf[:, :, 0], hf[:, :, 1]
    k = jnp.concatenate([fwd, jnp.zeros((1, HY_ORDER, D_MIX), f32), bwd[1:][::-1]], axis=0)
    k = k * lax.rsqrt(jnp.sum(k * k, axis=0, keepdims=True) + EPS)
    return k.transpose(1, 0, 2)


def fft_long_conv(z, k, skip):
    L = z.shape[1]
    zf = jnp.fft.rfft(z, n=2 * L, axis=1)
    kf = jnp.fft.rfft(k, axis=0)
    y = jnp.fft.irfft(zf * kf, n=2 * L, axis=1)[:, :L]
    return y + z * skip.astype(jnp.float32)


def hyena_branch(u, conv_w, conv_b, w1, b1, freq, w2, b2, w3, skip):
    L = u.shape[1]
    up = jnp.pad(u, ((0, 0), (1, 1), (0, 0)))
    uc = up[:, :-2] * conv_w[0] + up[:, 1:-1] * conv_w[1] + up[:, 2:] * conv_w[2] + conv_b
    x1, x2, v = jnp.split(uc.astype(jnp.float32), 3, axis=-1)
    filt = hyena_filters(L, w1, b1, freq, w2, b2, w3)
    z = x1 * fft_long_conv(v, filt[0], skip[0])
    z = x2 * fft_long_conv(z, filt[1], skip[1])
    return z.astype(u.dtype)


def fnet_branch(u):
    B, L, _ = u.shape
    ug = u.astype(jnp.float32).reshape(B, L, FN_GROUPS, D_MIX // FN_GROUPS)
    y = jnp.fft.fft2(ug, axes=(1, 3), norm="ortho").real
    return y.reshape(B, L, D_MIX).astype(u.dtype)


def rope_tables(L):
    inv = ROPE_THETA ** (-jnp.arange(0, MLA_ROPE, 2, dtype=jnp.float32) / MLA_ROPE)
    ang = jnp.arange(L, dtype=jnp.float32)[:, None] * inv
    return jnp.cos(ang), jnp.sin(ang)


def apply_rope(x, cos, sin):
    x1, x2 = jnp.split(x, 2, axis=-1)
    return jnp.concatenate([x1 * cos - x2 * sin, x2 * cos + x1 * sin], axis=-1).astype(x.dtype)


def mla_branch(c_q_raw, c_kv_raw, k_pe_raw, q_norm_g, w_uq, kv_norm_g, w_ukv):
    B, L, _ = c_q_raw.shape
    H = MLA_HEADS
    cos, sin = rope_tables(L)
    q = (rmsnorm(c_q_raw, q_norm_g) @ w_uq).reshape(B, L, H, MLA_NOPE + MLA_ROPE)
    q_nope, q_pe = q[..., :MLA_NOPE], apply_rope(q[..., MLA_NOPE:], cos[:, None], sin[:, None])
    kv = (rmsnorm(c_kv_raw, kv_norm_g) @ w_ukv).reshape(B, L, H, MLA_NOPE + MLA_V)
    k_nope, v = kv[..., :MLA_NOPE], kv[..., MLA_NOPE:]
    k_pe = apply_rope(k_pe_raw, cos, sin)
    scale = (MLA_NOPE + MLA_ROPE) ** -0.5
    nb = L // Q_BLOCK

    def block(args):
        qn, qp = args
        s = jnp.einsum('bqhd,bkhd->bhqk', qn, k_nope) + jnp.einsum('bqhr,bkr->bhqk', qp, k_pe)
        pr = jax.nn.softmax(s.astype(jnp.float32) * scale, axis=-1).astype(v.dtype)
        return jnp.einsum('bhqk,bkhd->bqhd', pr, v)

    qn_b = q_nope.reshape(B, nb, Q_BLOCK, H, MLA_NOPE).swapaxes(0, 1)
    qp_b = q_pe.reshape(B, nb, Q_BLOCK, H, MLA_ROPE).swapaxes(0, 1)
    o = lax.map(block, (qn_b, qp_b))
    return o.swapaxes(0, 1).reshape(B, L, H * MLA_V)


def neighborhood_branch(u, rpb):
    B, L, _ = u.shape
    H, d = NA_HEADS, NA_HEAD_DIM
    R = L // GRID_W
    wr = min(NA_WIN_R, R)
    q, k, v = jnp.split(u, 3, axis=-1)
    r = jnp.arange(R)
    rows = jnp.clip(r - wr // 2, 0, R - wr)[:, None] + jnp.arange(wr)
    c = jnp.arange(GRID_W)
    cs = jnp.clip(c - NA_WIN_C // 2, 0, GRID_W - NA_WIN_C)
    col_mask = (c[None, :] >= cs[:, None]) & (c[None, :] < cs[:, None] + NA_WIN_C)
    qg = q.reshape(B, R, GRID_W, H, d)
    kg = k.reshape(B, R, GRID_W, H, d)[:, rows]
    vg = v.reshape(B, R, GRID_W, H, d)[:, rows]
    s = jnp.einsum('brqhd,brikhd->bhrqik', qg, kg).astype(jnp.float32) * (d ** -0.5)
    dr = rows - r[:, None] + (NA_WIN_R - 1)
    dc = jnp.clip(c[None, :] - c[:, None] + (NA_WIN_C - 1), 0, 2 * NA_WIN_C - 2)
    bias = rpb.astype(jnp.float32)[:, dr][..., dc]
    s = s + bias.transpose(0, 1, 3, 2, 4)[None]
    s = jnp.where(col_mask[:, None, :], s, -jnp.inf)
    pr = jax.nn.softmax(s, axis=(-2, -1)).astype(u.dtype)
    o = jnp.einsum('bhrqik,brikhd->brqhd', pr, vg)
    return o.reshape(B, L, H * d)


def expert_choice_ffn(h, w_router, w_gate, w_up, w_down):
    B, L, D = h.shape
    cap = EC_CAPACITY_FACTOR * L // N_EXPERTS
    logits = jnp.einsum('bld,de->ble', h, w_router).astype(jnp.float32)
    aff = jax.nn.softmax(logits, axis=-1)
    top_aff, top_idx = lax.top_k(aff.transpose(0, 2, 1), cap)
    xe = jax.vmap(lambda hb, ib: hb[ib])(h, top_idx)
    g = jnp.einsum('becd,edf->becf', xe, w_gate)
    up = jnp.einsum('becd,edf->becf', xe, w_up)
    ye = jnp.einsum('becf,efd->becd', jax.nn.silu(g) * up, w_down)
    ye = ye * top_aff[..., None].astype(h.dtype)
    return jnp.zeros_like(h).at[jnp.arange(B)[:, None, None], top_idx].add(ye)


def mixer_sublayer(x, norm1_g, w_in, b_gate, hy_conv_w, hy_conv_b, hf_w1, hf_b1, hf_freq,
                   hf_w2, hf_b2, hf_w3, hy_skip, q_norm_g, w_uq, kv_norm_g, w_ukv, rpb,
                   w_br, w_out):
    B, L, D = x.shape
    h = rmsnorm(x, norm1_g)
    u = h @ w_in
    offsets = np.cumsum(IN_SIZES)[:-1].tolist()
    u_hy, u_fn, u_cq, u_ckv, u_kpe, u_na, u_gate = jnp.split(u, offsets, axis=-1)
    y_hy = hyena_branch(u_hy, hy_conv_w, hy_conv_b, hf_w1, hf_b1, hf_freq, hf_w2, hf_b2, hf_w3, hy_skip)
    y_fn = fnet_branch(u_fn)
    y_mla = mla_branch(u_cq, u_ckv, u_kpe, q_norm_g, w_uq, kv_norm_g, w_ukv)
    y_na = neighborhood_branch(u_na, rpb)
    branches = jnp.stack([y_hy, y_fn, y_mla, y_na], axis=2)
    proj = jnp.einsum('blnc,ncd->blnd', branches, w_br)
    gates = jax.nn.sigmoid(u_gate + b_gate).reshape(B, L, N_BRANCH, D)
    merged = jnp.sum(gates * proj, axis=2)
    return x + merged @ w_out


def setup_inputs(seed: int = 0) -> dict:
    key = jax.random.key(seed)
    ks = jax.random.split(key, 30)
    f32 = jnp.float32

    def nrm(k, shape, scale):
        return jax.random.normal(k, shape, f32) * scale

    def gain(k, shape):
        return 1.0 + 0.01 * jax.random.normal(k, shape, f32)

    return {
        "x": nrm(ks[0], (BATCH, SEQ, D_MODEL), 1.0),
        "p": nrm(ks[1], (DEPTH, BATCH, SEQ, PLE_DIM), 1.0),
        "norm1_g": gain(ks[2], (DEPTH, D_MODEL)),
        "w_in": nrm(ks[3], (DEPTH, D_MODEL, IN_COLS), D_MODEL ** -0.5),
        "b_gate": nrm(ks[4], (DEPTH, GATE_COLS), 0.02),
        "hy_conv_w": nrm(ks[5], (DEPTH, HY_SHORT, HY_COLS), HY_SHORT ** -0.5),
        "hy_conv_b": nrm(ks[6], (DEPTH, HY_COLS), 0.02),
        "hf_w1": nrm(ks[7], (DEPTH, HY_EMB, HY_FFN), HY_EMB ** -0.5),
        "hf_b1": nrm(ks[8], (DEPTH, HY_FFN), 0.02),
        "hf_freq": gain(ks[9], (DEPTH, 2, HY_FFN)),
        "hf_w2": nrm(ks[10], (DEPTH, HY_FFN, HY_FFN), HY_FFN ** -0.5),
        "hf_b2": nrm(ks[11], (DEPTH, HY_FFN), 0.02),
        "hf_w3": nrm(ks[12], (DEPTH, HY_FFN, HY_ORDER * 2 * D_MIX), HY_FFN ** -0.5),
        "hy_skip": nrm(ks[13], (DEPTH, HY_ORDER, D_MIX), 0.5),
        "q_norm_g": gain(ks[14], (DEPTH, MLA_Q_RANK)),
        "w_uq": nrm(ks[15], (DEPTH, MLA_Q_RANK, MLA_HEADS * (MLA_NOPE + MLA_ROPE)), MLA_Q_RANK ** -0.5),
        "kv_norm_g": gain(ks[16], (DEPTH, MLA_KV_RANK)),
        "w_ukv": nrm(ks[17], (DEPTH, MLA_KV_RANK, MLA_HEADS * (MLA_NOPE + MLA_V)), MLA_KV_RANK ** -0.5),
        "rpb": nrm(ks[18], (DEPTH, NA_HEADS, 2 * NA_WIN_R - 1, 2 * NA_WIN_C - 1), 0.02),
        "w_br": nrm(ks[19], (DEPTH, N_BRANCH, D_MIX, D_MODEL), D_MIX ** -0.5),
        "w_out": nrm(ks[20], (DEPTH, D_MODEL, D_MODEL), D_MODEL ** -0.5),
        "norm2_g": gain(ks[21], (DEPTH, D_MODEL)),
        "w_router": nrm(ks[22], (DEPTH, D_MODEL, N_EXPERTS), D_MODEL ** -0.5),
        "w_e_gate": nrm(ks[23], (DEPTH, N_EXPERTS, D_MODEL, D_FF_EXPERT), D_MODEL ** -0.5),
        "w_e_up": nrm(ks[24], (DEPTH, N_EXPERTS, D_MODEL, D_FF_EXPERT), D_MODEL ** -0.5),
        "w_e_down": nrm(ks[25], (DEPTH, N_EXPERTS, D_FF_EXPERT, D_MODEL), D_FF_EXPERT ** -0.5),
        "norm3_g": gain(ks[26], (DEPTH, D_MODEL)),
        "w_ple_gate": nrm(ks[27], (DEPTH, D_MODEL, D_MODEL), D_MODEL ** -0.5),
        "w_ple_proj": nrm(ks[28], (DEPTH, PLE_DIM, D_MODEL), PLE_DIM ** -0.5),
        "final_g": gain(ks[29], (D_MODEL,)),
    }


def reference(x, p, norm1_g, w_in, b_gate, hy_conv_w, hy_conv_b, hf_w1, hf_b1, hf_freq,
              hf_w2, hf_b2, hf_w3, hy_skip, q_norm_g, w_uq, kv_norm_g, w_ukv, rpb, w_br,
              w_out, norm2_g, w_router, w_e_gate, w_e_up, w_e_down, norm3_g, w_ple_gate,
              w_ple_proj, final_g):
    for i in range(DEPTH):
        x = mixer_sublayer(x, norm1_g[i], w_in[i], b_gate[i], hy_conv_w[i], hy_conv_b[i],
                           hf_w1[i], hf_b1[i], hf_freq[i], hf_w2[i], hf_b2[i], hf_w3[i],
                           hy_skip[i], q_norm_g[i], w_uq[i], kv_norm_g[i], w_ukv[i], rpb[i],
                           w_br[i], w_out[i])
        x = x + expert_choice_ffn(rmsnorm(x, norm2_g[i]), w_router[i], w_e_gate[i],
                                  w_e_up[i], w_e_down[i])
        gate = jax.nn.sigmoid(rmsnorm(x, norm3_g[i]) @ w_ple_gate[i])
        x = x + gate * (p[i] @ w_ple_proj[i])
    return rmsnorm(x, final_g)
```

```cpp
#include <hip/hip_runtime.h>
#include <cstdio>
#include <cstdint>
namespace pg8 {
#define PG8_LAS __attribute__((address_space(3)))
typedef unsigned short bf16_t;
typedef short bf16x8 __attribute__((ext_vector_type(8)));
typedef float f32x4 __attribute__((ext_vector_type(4)));
typedef unsigned u32x4 __attribute__((ext_vector_type(4)));
constexpr int BM = 256, BK = 64, HALF = 128, HTB = HALF * BK * 2  , STAGE_BYTES = 8 * HTB, NXCD = 8, WGM = 8;

__host__ __device__ __forceinline__ int lds_byte(int r, int c) { const int st = (r >> 4) * 2 + (c >> 5), rr = r & 15, cc = c & 31, ob = rr * 64 + cc * 2; return st * 1024 + (ob ^ (((ob >> 9) & 1) << 5)); }
__host__ __device__ __forceinline__ void stage_rc(int b, int& R, int& C) { const int st = b / 1024, sb = b % 1024, swz = sb ^ (((sb >> 9) & 1) << 5); R = (st >> 1) * 16 + swz / 64; C = (st & 1) * 32 + (swz % 64) / 2; }
__host__ __device__ __forceinline__ int perm32(int rho) { const int n = rho >> 4, i = rho & 15; return 8 * (i >> 2) + 4 * n + (i & 3); }

struct Unit { int pm, pn; };
struct Gemm { const bf16_t* A; const bf16_t* Bt; int M, N, K; };

struct StaticOrder {
    int nM, nN, nwg, G, c;
    __host__ __device__ void init(int M, int N, int G_, int c_) { nM = M / BM; nN = N / BM; nwg = nM * nN; G = G_; c = c_; }
    __host__ __device__ bool next(int i, Unit& u) const {
        const long L = (long)i * G + c; if (L >= nwg) return false;
        int wgid = (int)L; { const int q = nwg / NXCD, r = nwg % NXCD, xcd = wgid % NXCD, off = wgid / NXCD; wgid = (xcd < r ? xcd * (q + 1) : r * (q + 1) + (xcd - r) * q) + off; }
        const int nig = WGM * nN, gid = wgid / nig, fm = gid * WGM, gsz = (nM - fm) < WGM ? (nM - fm) : WGM;
        u.pm = fm + ((wgid % nig) % gsz); u.pn = (wgid % nig) / gsz; return true;
    }
    __device__ __forceinline__ void a_ready(const Unit&) const {}
    __device__ __forceinline__ void done(const Unit&) const {}
};
__device__ __forceinline__ unsigned cvt_pk_bf16(float lo, float hi) { unsigned r; asm volatile("v_cvt_pk_bf16_f32 %0, %1, %2" : "=v"(r) : "v"(lo), "v"(hi)); return r; }
template <class Epi, class Sched, bool ALIGN_EPI = false, bool SP2 = false>
__device__ __forceinline__ void gemm_phase(PG8_LAS unsigned char* lds, const Gemm g, const Sched& S, const Epi& E) {
    int tid_ = threadIdx.x; asm volatile("" : "+v"(tid_));
    const int tid = tid_, wid = __builtin_amdgcn_readfirstlane(tid >> 6), lane = tid & 63, wr = wid >> 2, wc = wid & 3, fr = lane & 15, fq = lane >> 4;
    int K_ = g.K; asm volatile("" : "+s"(K_));
    const int K = K_, nt = K / BK;
    unsigned voffA[2], voffB[2];
#pragma unroll
    for (int i = 0; i < 2; ++i) { int R, C; stage_rc(tid * 16 + i * 8192, R, C); const int Rb = Epi::PERM ? ((R & ~31) + perm32(R & 31)) : R;
        voffA[i] = (unsigned)(R * K + C) * 2u; voffB[i] = (unsigned)(Rb * K + C) * 2u; }
    const size_t kstep = (size_t)(BK * 2);
    const size_t hstep = (size_t)HALF * K * 2;
    const size_t tstep = 2 * hstep;
    const unsigned ldsw = (unsigned)wid * 1024u;
    const int aoff = lds_byte(wr * 64 + fr, fq * 8), boff = lds_byte(wc * 32 + fr, fq * 8);
#define PG8_SA(b, h) (((b) * 2 + (h)) * HTB)
#define PG8_SB(b, h) ((4 + (b) * 2 + (h)) * HTB)
#define PG8_STAGE(bufoff, gbase, voff) do { _Pragma("unroll") for (int _i = 0; _i < 2; ++_i) \
        __builtin_amdgcn_global_load_lds((const unsigned*)((const char*)(gbase) + (voff)[_i]), (PG8_LAS unsigned*)(lds + (bufoff) + ldsw + _i * 8192), 16, 0, 0); } while (0)
#define PG8_LDA(dst, b, h) do { _Pragma("unroll") for (int m = 0; m < 4; ++m) _Pragma("unroll") for (int k = 0; k < 2; ++k) dst[m][k] = *(const PG8_LAS bf16x8*)(lds + PG8_SA(b, h) + aoff + m * 2048 + k * 1024); } while (0)
#define PG8_LDB(dst, b, h) do { _Pragma("unroll") for (int n = 0; n < 2; ++n) _Pragma("unroll") for (int k = 0; k < 2; ++k) dst[n][k] = *(const PG8_LAS bf16x8*)(lds + PG8_SB(b, h) + boff + n * 2048 + k * 1024); } while (0)
#define PG8_MMA(ai, bj, At, Bt) do { __builtin_amdgcn_s_setprio(1); _Pragma("unroll") for (int m = 0; m < 4; ++m) _Pragma("unroll") for (int n = 0; n < 2; ++n) _Pragma("unroll") for (int k = 0; k < 2; ++k) \
        acc[ai][bj][m][n] = __builtin_amdgcn_mfma_f32_16x16x32_bf16(Bt[n][k], At[m][k], acc[ai][bj][m][n], 0, 0, 0); __builtin_amdgcn_s_setprio(0); } while (0)
#define PG8_WAIT_V(n) asm volatile("s_waitcnt vmcnt(" #n ")" ::: "memory")
#define PG8_WAIT_L(n) asm volatile("s_waitcnt lgkmcnt(" #n ")" ::: "memory")
#define PG8_BAR __builtin_amdgcn_s_barrier()
#define PG8_SCHED __builtin_amdgcn_sched_barrier(0)
    Unit cur, nxt; int ui = 0;
    if (!S.next(0, cur)) return;
    f32x4 acc[2][2][4][2];
#pragma unroll
    for (int a = 0; a < 2; ++a)
#pragma unroll
        for (int b = 0; b < 2; ++b)
#pragma unroll
            for (int m = 0; m < 4; ++m)
#pragma unroll
                for (int n = 0; n < 2; ++n) acc[a][b][m][n] = (f32x4){0.f, 0.f, 0.f, 0.f};
    bf16x8 At[4][2], B0[2][2], B1[2][2];
    const char* cA = (const char*)g.A + (size_t)cur.pm * tstep; const char* cB = (const char*)g.Bt + (size_t)cur.pn * tstep;
    S.a_ready(cur);
    if constexpr (SP2) {
        PG8_STAGE(PG8_SB(0, 0), cB, voffB); PG8_STAGE(PG8_SB(0, 1), cB + hstep, voffB); PG8_STAGE(PG8_SA(0, 0), cA, voffA); PG8_STAGE(PG8_SA(0, 1), cA + hstep, voffA);
        if (wr == 1) PG8_BAR;
        PG8_WAIT_V(2); PG8_BAR;
        PG8_STAGE(PG8_SB(1, 0), cB + kstep, voffB); PG8_STAGE(PG8_SA(1, 0), cA + kstep, voffA); PG8_STAGE(PG8_SB(1, 1), cB + hstep + kstep, voffB);
        PG8_WAIT_V(6); PG8_BAR;
    } else {
        PG8_STAGE(PG8_SB(0, 0), cB, voffB); PG8_STAGE(PG8_SA(0, 0), cA, voffA); PG8_STAGE(PG8_SB(0, 1), cB + hstep, voffB); PG8_STAGE(PG8_SA(0, 1), cA + hstep, voffA);
        if (wr == 1) PG8_BAR;
        PG8_WAIT_V(4); PG8_BAR;
        PG8_STAGE(PG8_SB(1, 0), cB + kstep, voffB); PG8_STAGE(PG8_SA(1, 0), cA + kstep, voffA); PG8_STAGE(PG8_SB(1, 1), cB + hstep + kstep, voffB);
        PG8_WAIT_V(6); PG8_BAR;
    }
    for (;;) {
        const bool has_next = S.next(ui + 1, nxt);
        const char* nA = has_next ? (const char*)g.A + (size_t)nxt.pm * tstep : cA; const char* nB = has_next ? (const char*)g.Bt + (size_t)nxt.pn * tstep : cB;
        for (int t = 0; t < nt; t += 2) {
            const bool last = (t == nt - 2);
            const char* a1 = cA + (size_t)(t + 1) * kstep;
            const char* a2 = last ? nA : cA + (size_t)(t + 2) * kstep; const char* b2 = last ? nB : cB + (size_t)(t + 2) * kstep;
            const char* a3 = a2 + kstep; const char* b3 = b2 + kstep;
            if (last && has_next) S.a_ready(nxt);
            if constexpr (SP2) {
            PG8_LDB(B0, 0, 0); PG8_LDB(B1, 0, 1); PG8_SCHED; PG8_LDA(At, 0, 0); PG8_STAGE(PG8_SA(1, 1), a1 + hstep, voffA);
            PG8_WAIT_V(8); PG8_WAIT_L(0); PG8_BAR; PG8_MMA(0, 0, At, B0); PG8_MMA(0, 1, At, B1); PG8_BAR; PG8_SCHED;
            PG8_LDA(At, 0, 1); PG8_STAGE(PG8_SB(0, 0), b2, voffB); PG8_STAGE(PG8_SB(0, 1), b2 + hstep, voffB); PG8_STAGE(PG8_SA(0, 0), a2, voffA);
            PG8_WAIT_V(8); PG8_WAIT_L(0); PG8_BAR; PG8_MMA(1, 0, At, B0); PG8_MMA(1, 1, At, B1); PG8_BAR; PG8_SCHED;
            PG8_LDB(B0, 1, 0); PG8_LDB(B1, 1, 1); PG8_SCHED; PG8_LDA(At, 1, 0); PG8_STAGE(PG8_SA(0, 1), a2 + hstep, voffA);
            PG8_WAIT_V(8); PG8_WAIT_L(0); PG8_BAR; PG8_MMA(0, 0, At, B0); PG8_MMA(0, 1, At, B1); PG8_BAR; PG8_SCHED;
            PG8_LDA(At, 1, 1); PG8_STAGE(PG8_SB(1, 0), b3, voffB); PG8_STAGE(PG8_SB(1, 1), b3 + hstep, voffB); PG8_STAGE(PG8_SA(1, 0), a3, voffA);
            PG8_WAIT_V(8); PG8_WAIT_L(0); PG8_BAR; PG8_MMA(1, 0, At, B0); PG8_MMA(1, 1, At, B1); PG8_BAR; PG8_SCHED;
            } else {
            PG8_LDB(B0, 0, 0); PG8_SCHED; PG8_LDA(At, 0, 0); PG8_STAGE(PG8_SA(1, 1), a1 + hstep, voffA);
            PG8_WAIT_L(8); PG8_BAR; PG8_WAIT_L(0); PG8_MMA(0, 0, At, B0); PG8_BAR; PG8_SCHED;
            PG8_LDB(B1, 0, 1); PG8_STAGE(PG8_SB(0, 0), b2, voffB);
            PG8_BAR; PG8_WAIT_L(0); PG8_MMA(0, 1, At, B1); PG8_BAR;
            PG8_LDA(At, 0, 1); PG8_STAGE(PG8_SA(0, 0), a2, voffA);
            PG8_BAR; PG8_WAIT_L(0); PG8_MMA(1, 0, At, B0); PG8_BAR; PG8_SCHED;
            PG8_STAGE(PG8_SB(0, 1), b2 + hstep, voffB);
            PG8_WAIT_V(6); PG8_BAR; PG8_MMA(1, 1, At, B1); PG8_BAR;
            PG8_LDB(B0, 1, 0); PG8_SCHED; PG8_LDA(At, 1, 0); PG8_STAGE(PG8_SA(0, 1), a2 + hstep, voffA);
            PG8_WAIT_L(8); PG8_BAR; PG8_WAIT_L(0); PG8_MMA(0, 0, At, B0); PG8_BAR; PG8_SCHED;
            PG8_LDB(B1, 1, 1); PG8_STAGE(PG8_SB(1, 0), b3, voffB);
            PG8_BAR; PG8_WAIT_L(0); PG8_MMA(0, 1, At, B1); PG8_BAR;
            PG8_LDA(At, 1, 1); PG8_STAGE(PG8_SA(1, 0), a3, voffA);
            PG8_BAR; PG8_WAIT_L(0); PG8_MMA(1, 0, At, B0); PG8_BAR; PG8_SCHED;
            PG8_STAGE(PG8_SB(1, 1), b3 + hstep, voffB);
            PG8_WAIT_V(6); PG8_BAR; PG8_MMA(1, 1, At, B1); PG8_BAR;
            }
        }
        if constexpr (ALIGN_EPI) { if (wr == 0) PG8_BAR; }
        if constexpr (!Epi::AFTER_DRAIN) { E(acc, cur, wr, wc, fr, fq); S.done(cur); }
        if (!has_next) break;
#pragma unroll
        for (int a = 0; a < 2; ++a)
#pragma unroll
            for (int b = 0; b < 2; ++b)
#pragma unroll
                for (int m = 0; m < 4; ++m)
#pragma unroll
                    for (int n = 0; n < 2; ++n) acc[a][b][m][n] = (f32x4){0.f, 0.f, 0.f, 0.f};
        cur = nxt; cA = nA; cB = nB; ++ui;
        if constexpr (ALIGN_EPI) { if (wr == 1) PG8_BAR; }
    }
    PG8_WAIT_V(0);
    if constexpr (!ALIGN_EPI) { if (wr == 0) PG8_BAR; }
    PG8_BAR;
    if constexpr (Epi::AFTER_DRAIN) { E.fused(acc, cur, wr, wc, fr, fq, lds, wid, lane); S.done(cur); }
#undef PG8_SA
#undef PG8_SB
#undef PG8_STAGE
#undef PG8_LDA
#undef PG8_LDB
#undef PG8_MMA
#undef PG8_WAIT_V
#undef PG8_WAIT_L
#undef PG8_BAR
#undef PG8_SCHED
}
}
#define GAS __attribute__((address_space(1)))
#define LAS __attribute__((address_space(3)))
typedef unsigned short bf16;
typedef unsigned v4u __attribute__((ext_vector_type(4)));
typedef float f32x4 __attribute__((ext_vector_type(4)));
typedef short bf16x8 __attribute__((ext_vector_type(8)));
typedef GAS unsigned gu32;
typedef GAS unsigned long long gu64;
#define RLX_AGENT __ATOMIC_RELAXED, __HIP_MEMORY_SCOPE_AGENT
#define LDS_WAIT() asm volatile("s_waitcnt lgkmcnt(0)" ::: "memory")
#define VM_WAIT() asm volatile("s_waitcnt vmcnt(0)" ::: "memory")
__device__ __forceinline__ unsigned long long rt() { return __builtin_amdgcn_s_memrealtime(); }
__device__ __forceinline__ unsigned f2bf(float f) { unsigned u = __builtin_bit_cast(unsigned, f); return (u + 0x7fffu + ((u >> 16) & 1u)) >> 16; }
__device__ __forceinline__ unsigned pk2(float lo, float hi) { return f2bf(lo) | (f2bf(hi) << 16); }
#define XB_TMO      128
#define XB_XCNT(j)  (256  + 64 * (j))
#define XB_XSUB(j)  (1280 + 64 * (j))
#define XB_XGEN(j)  (2304 + 64 * (j))
#define XB_TOP      3328
#define XB_TOPGEN   3392
#define XCD_BAR_WORDS 3456
#define XB_SPIN_CAP (1u << 18)

__device__ __forceinline__ unsigned xb_ld(unsigned* p)              { return __hip_atomic_load(p, __ATOMIC_RELAXED, __HIP_MEMORY_SCOPE_AGENT); }
__device__ __forceinline__ unsigned xb_add(unsigned* p, unsigned v) { return __hip_atomic_fetch_add(p, v, __ATOMIC_RELAXED, __HIP_MEMORY_SCOPE_AGENT); }
__device__ __forceinline__ unsigned xb_xcc_id() { return (unsigned)__builtin_amdgcn_s_getreg((3 << 11) | 20) & 0xFu; }
#define XB_SPIN(cond, bar) do { unsigned _sp = 0; while (cond) { __builtin_amdgcn_s_sleep(1); \
    if ((++_sp & 255u) == 0u) { if (xb_ld(&(bar)[XB_TMO])) break; if (_sp > XB_SPIN_CAP) { atomicAdd(&(bar)[XB_TMO], 1u); break; } } } } while (0)

struct XcdBarrier {
    unsigned* bar; unsigned x;
    volatile LAS unsigned* st;
};

__device__ __forceinline__ XcdBarrier xcd_barrier_post(unsigned* bar, volatile LAS unsigned* st) {
    XcdBarrier b; b.bar = bar; b.x = xb_xcc_id(); b.st = st;
    if (threadIdx.x == 0) (void)xb_add(&bar[XB_XCNT(b.x)], 1u);
    return b;
}
__device__ __forceinline__ void xcd_barrier_complete(unsigned* bar, unsigned x, unsigned& nloc, unsigned& nx) {
    const unsigned G = gridDim.x * gridDim.y * gridDim.z;
    unsigned sum, cnt, mine, sp = 0u;
    for (;;) {
        sum = 0u; cnt = 0u; mine = 0u;
#pragma unroll
        for (unsigned j = 0; j < 16; ++j) { const unsigned c = xb_ld(&bar[XB_XCNT(j)]); sum += c; cnt += (c > 0u) ? 1u : 0u; mine = (j == x) ? c : mine; }
        if (sum == G) break;
        __builtin_amdgcn_s_sleep(1);
        if ((++sp & 255u) == 0u) { if (xb_ld(&bar[XB_TMO])) break; if (sp > XB_SPIN_CAP) { atomicAdd(&bar[XB_TMO], 1u); break; } }
    }
    nloc = mine > 0u ? mine : 1u; nx = cnt > 0u ? cnt : 1u;
}

__device__ __forceinline__ void xcd_barrier(const XcdBarrier& b) {
    asm volatile("s_waitcnt vmcnt(0)" ::: "memory");
    __syncthreads();
    if (threadIdx.x == 0) {
        unsigned* bar = b.bar;
        __builtin_amdgcn_s_waitcnt(0);
        unsigned nloc = b.st[0], nx = b.st[1];
        if (nloc == 0u) { xcd_barrier_complete(bar, b.x, nloc, nx); b.st[0] = nloc; b.st[1] = nx; }
        const unsigned old = xb_add(&bar[XB_XSUB(b.x)], 1u);
        const unsigned gen = old / nloc;
        if (old + 1u == (gen + 1u) * nloc) {
            __builtin_amdgcn_fence(__ATOMIC_RELEASE, "agent");
            asm volatile("s_waitcnt vmcnt(0)" ::: "memory");
            const unsigned og = xb_add(&bar[XB_TOP], 1u);
            const unsigned tg = og / nx;
            if (og + 1u == (tg + 1u) * nx) xb_add(&bar[XB_TOPGEN], 1u);
            else XB_SPIN(xb_ld(&bar[XB_TOPGEN]) == tg, bar);
            __builtin_amdgcn_fence(__ATOMIC_ACQUIRE, "agent");
            xb_add(&bar[XB_XGEN(b.x)], 1u);
            asm volatile("s_waitcnt vmcnt(0)" ::: "memory");
        } else {
            XB_SPIN(xb_ld(&bar[XB_XGEN(b.x)]) == gen, bar);
            __builtin_amdgcn_fence(__ATOMIC_ACQUIRE, "agent");
            asm volatile("s_waitcnt vmcnt(0)" ::: "memory");
        }
    }
    __syncthreads();
}

constexpr int NWAVES = 8, NTHR = 512;
constexpr int NB = 8, SEQ = 2048, DM = 1024, TOK = NB * SEQ;
constexpr int IN_COLS = 6304, NWIN = 6400;
constexpr int NEXP = 16, CAP = 256, NSLOT = NB * NEXP * CAP;
constexpr float EPS = 1e-6f;
constexpr float LOG2E = 1.4426950408889634f;
typedef float f32x16 __attribute__((ext_vector_type(16)));
typedef float f32x2 __attribute__((ext_vector_type(2)));
typedef unsigned u32x2 __attribute__((ext_vector_type(2)));

constexpr size_t MiB = 1u << 20;
constexpr size_t WS_CTL = 0, CTL_ZERO_BYTES = 1 * MiB;
constexpr size_t WS_STAT = 1 * MiB;
constexpr size_t WS_SSP = 29 * MiB;
constexpr size_t WS_AFF = 2 * MiB;
constexpr size_t WS_INV = 3 * MiB;
constexpr size_t WS_SEL = 4 * MiB;
constexpr size_t WS_ROPE = 4 * MiB + 512 * 1024;
constexpr size_t WS_KT = 5 * MiB;
constexpr size_t WS_KF = 13 * MiB;
constexpr size_t WS_WIN = 32 * MiB;
constexpr size_t WS_WUQ = 45 * MiB;
constexpr size_t WS_WUKV = WS_WUQ + 512 * 256 * 2;
constexpr size_t WS_WBR = 46 * MiB;
constexpr size_t WS_WOUT = 48 * MiB;
constexpr size_t WS_WPG = 50 * MiB;
constexpr size_t WS_WPP = 52 * MiB;
constexpr size_t WS_WE1 = 54 * MiB;
constexpr size_t WS_WE2 = 118 * MiB;
constexpr size_t WS_XB = 150 * MiB;
constexpr size_t WS_PB = 182 * MiB;
constexpr size_t WS_UHYT = 190 * MiB;
constexpr size_t WS_UFNT = 214 * MiB;
constexpr size_t WS_CQ = 222 * MiB;
constexpr size_t WS_CKV = 230 * MiB;
constexpr size_t WS_NAQ = 238 * MiB;
constexpr size_t WS_NAK = 246 * MiB;
constexpr size_t WS_NAVT = 254 * MiB;
constexpr size_t WS_MPART = 190 * MiB;
constexpr size_t WS_GATES = 262 * MiB;
constexpr size_t WS_XE = 262 * MiB;
constexpr size_t WS_HB = 326 * MiB;
constexpr size_t WS_Q = 390 * MiB;
constexpr size_t WS_KFULL = 402 * MiB;
constexpr size_t WS_VT = 414 * MiB;
constexpr size_t WS_YHY = 422 * MiB, WS_YFN = 430 * MiB, WS_YMLA = 438 * MiB, WS_YNA = 446 * MiB;
constexpr size_t WS_MERGED = 454 * MiB;
constexpr size_t WS_END = 486 * MiB;
constexpr int CW_TMO = 0, CW_BAR = 4096;

constexpr int RING_BYTES = 131072;
constexpr int LDS_BYTES = 147456;
constexpr int LDSCTL_OFF = LDS_BYTES - 256;

struct Args {
    const float* in[30]; float* out; unsigned char* ws; int ph_lo, ph_hi;
};
struct Frame {
    LAS unsigned char* lds;
    int tid, lane, wave, vcu, G;

};

__device__ __forceinline__ float bf2f(unsigned short h) { return __builtin_bit_cast(float, (unsigned)h << 16); }
__device__ __forceinline__ unsigned cvtpk(float lo, float hi) { return pg8::cvt_pk_bf16(lo, hi); }
__device__ __forceinline__ float wave_sum(float v) {
#pragma unroll
    for (int o = 1; o < 64; o <<= 1) v += __shfl_xor(v, o);
    return v;
}
__device__ __forceinline__ float fast_exp2(float x) { return __builtin_amdgcn_exp2f(x); }
__device__ __forceinline__ float sigmoidf_(float x) { return 1.0f / (1.0f + __expf(-x)); }

__device__ __forceinline__ int fpad(int i) { return i + (i >> 3); }
__device__ __forceinline__ f32x2 cmul(f32x2 a, f32x2 b) { return (f32x2){a.x * b.x - a.y * b.y, a.x * b.y + a.y * b.x}; }
__device__ __forceinline__ f32x2 cmulc(f32x2 a, f32x2 b) { return (f32x2){a.x * b.x + a.y * b.y, a.y * b.x - a.x * b.y}; }
template <bool INV> __device__ __forceinline__ void dft8(f32x2 (&x)[8]) {
    const float R = 0.70710678118654752f;
    f32x2 a[4], b[4];
#pragma unroll
    for (int k = 0; k < 4; ++k) { a[k] = x[k] + x[k + 4]; b[k] = x[k] - x[k + 4]; }
    if (!INV) {
        b[1] = (f32x2){(b[1].x + b[1].y) * R, (b[1].y - b[1].x) * R};
        b[2] = (f32x2){b[2].y, -b[2].x};
        b[3] = (f32x2){(-b[3].x + b[3].y) * R, (-b[3].x - b[3].y) * R};
    } else {
        b[1] = (f32x2){(b[1].x - b[1].y) * R, (b[1].x + b[1].y) * R};
        b[2] = (f32x2){-b[2].y, b[2].x};
        b[3] = (f32x2){(-b[3].x - b[3].y) * R, (b[3].x - b[3].y) * R};
    }
    {
        f32x2 e0 = a[0] + a[2], e1 = a[0] - a[2], f0 = a[1] + a[3], d = a[1] - a[3];
        f32x2 f1 = INV ? (f32x2){-d.y, d.x} : (f32x2){d.y, -d.x};
        x[0] = e0 + f0; x[2] = e1 + f1; x[4] = e0 - f0; x[6] = e1 - f1;
    }
    {
        f32x2 e0 = b[0] + b[2], e1 = b[0] - b[2], f0 = b[1] + b[3], d = b[1] - b[3];
        f32x2 f1 = INV ? (f32x2){-d.y, d.x} : (f32x2){d.y, -d.x};
        x[1] = e0 + f0; x[3] = e1 + f1; x[5] = e0 - f0; x[7] = e1 - f1;
    }
}
template <int S> __device__ __forceinline__ void fft_stage_fwd(LAS f32x2* buf, const LAS f32x2* tw, int tid) {
    constexpr int q = 512 >> (3 * S), n = 8 * q, tws = 512 / q;
    const int blk = tid / q, j = tid % q, base = blk * n + j;
    f32x2 x[8];
#pragma unroll
    for (int k = 0; k < 8; ++k) x[k] = buf[fpad(base + k * q)];
    dft8<false>(x);
    if (S < 3) {
#pragma unroll
        for (int m = 1; m < 8; ++m) x[m] = cmul(x[m], tw[(j * m * tws) & 4095]);
    }
#pragma unroll
    for (int k = 0; k < 8; ++k) buf[fpad(base + k * q)] = x[k];
}
template <int S> __device__ __forceinline__ void fft_stage_inv(LAS f32x2* buf, const LAS f32x2* tw, int tid) {
    constexpr int q = 512 >> (3 * S), n = 8 * q, tws = 512 / q;
    const int blk = tid / q, j = tid % q, base = blk * n + j;
    f32x2 x[8];
#pragma unroll
    for (int k = 0; k < 8; ++k) x[k] = buf[fpad(base + k * q)];
    if (S < 3) {
#pragma unroll
        for (int m = 1; m < 8; ++m) x[m] = cmulc(x[m], tw[(j * m * tws) & 4095]);
    }
    dft8<true>(x);
#pragma unroll
    for (int k = 0; k < 8; ++k) buf[fpad(base + k * q)] = x[k];
}
__device__ __forceinline__ void fft_fwd(LAS f32x2* buf, const LAS f32x2* tw, int tid) {
    fft_stage_fwd<0>(buf, tw, tid); __syncthreads();
    fft_stage_fwd<1>(buf, tw, tid); __syncthreads();
    fft_stage_fwd<2>(buf, tw, tid); __syncthreads();
    fft_stage_fwd<3>(buf, tw, tid); __syncthreads();
}
__device__ __forceinline__ void fft_inv(LAS f32x2* buf, const LAS f32x2* tw, int tid) {
    fft_stage_inv<3>(buf, tw, tid); __syncthreads();
    fft_stage_inv<2>(buf, tw, tid); __syncthreads();
    fft_stage_inv<1>(buf, tw, tid); __syncthreads();
    fft_stage_inv<0>(buf, tw, tid); __syncthreads();
}
__device__ __forceinline__ int digrev(int f) { return ((f & 7) << 9) | (((f >> 3) & 7) << 6) | (((f >> 6) & 7) << 3) | ((f >> 9) & 7); }
constexpr int FFT_BUF_OFF = 0, FFT_TW_OFF = 36864, FFT_STAGE_OFF = 69632;
__device__ __forceinline__ void fft_init_tw(const Args& A, Frame& F) {
    LAS f32x2* tw = (LAS f32x2*)(F.lds + FFT_TW_OFF);
    for (int k = F.tid; k < 4096; k += NTHR) { float s, c; sincospif((float)k * (1.0f / 2048.0f), &s, &c); tw[k] = (f32x2){c, -s}; }
    __syncthreads();
}

__device__ __forceinline__ void phase_p0(const Args& A, Frame& F) {
    const float* x = A.in[0]; float* ss = (float*)(A.ws + WS_STAT); bf16* xb = (bf16*)(A.ws + WS_XB);
    const int gw = F.vcu * NWAVES + F.wave, NGW = F.G * NWAVES;
    for (int row = gw; row < TOK; row += NGW) {
        const f32x4* xr = (const f32x4*)(x + (size_t)row * DM) + F.lane; f32x4* orow = (f32x4*)(A.out + (size_t)row * DM) + F.lane;
        u32x2* brow = (u32x2*)(xb + (size_t)row * DM) + F.lane;
        float s = 0.f;
#pragma unroll
        for (int j = 0; j < 4; ++j) { const f32x4 v = xr[64 * j]; s += (v.x * v.x + v.y * v.y) + (v.z * v.z + v.w * v.w); orow[64 * j] = v; brow[64 * j] = (u32x2){cvtpk(v.x, v.y), cvtpk(v.z, v.w)}; }
        s = wave_sum(s);
        if (F.lane == 0) ss[row] = s;
    }
    float* rc = (float*)(A.ws + WS_ROPE);
    for (int i = F.vcu * NTHR + F.tid; i < SEQ * 16; i += F.G * NTHR) { const float invf = exp2f(-(float)(i & 15) * (13.287712379549449f / 16.0f)); float sn, cs; sincosf((float)(i >> 4) * invf, &sn, &cs); rc[i] = cs; rc[SEQ * 16 + i] = sn; }
}

__device__ __forceinline__ void tr_item(const float* W, int ldw, const float* g, float cs, bf16* WT, int ldt, int k0, int sn0, int dn0, LAS float* scr, int lane) {
#pragma unroll 8
    for (int i = 0; i < 32; ++i) { const int kk = 2 * i + (lane >> 5); const float gv = g ? g[k0 + kk] * cs : cs;
        scr[kk * 33 + (lane & 31)] = W[(size_t)(k0 + kk) * ldw + sn0 + (lane & 31)] * gv; }
    LDS_WAIT(); asm volatile("" ::: "memory");
    const int c = lane & 7;
#pragma unroll
    for (int j = 0; j < 4; ++j) { const int n = (lane >> 3) + 8 * j; const LAS float* s = scr + (8 * c) * 33 + n;
        v4u o; o.x = cvtpk(s[0 * 33], s[1 * 33]); o.y = cvtpk(s[2 * 33], s[3 * 33]); o.z = cvtpk(s[4 * 33], s[5 * 33]); o.w = cvtpk(s[6 * 33], s[7 * 33]);
        *(v4u*)(WT + (size_t)(dn0 + n) * ldt + k0 + 8 * c) = o; }
    LDS_WAIT(); asm volatile("" ::: "memory");
}
__device__ __forceinline__ void fn_fold_item(const float* W, const float* g1, bf16* WT, int k0, int grp, LAS float* scr, int lane) {
#pragma unroll 8
    for (int i = 0; i < 64; ++i) scr[i * 64 + lane] = W[(size_t)(k0 + i) * IN_COLS + 768 + 64 * grp + lane] * g1[k0 + i];
    LDS_WAIT(); asm volatile("" ::: "memory");
    const int j = lane, m = j <= 32 ? j : j - 32; const float sc = 1.0f / 362.03867196751236f;
    float Dr[64];
#pragma unroll
    for (int c = 0; c < 64; ++c) { float s, co; sincospif((float)((m * c) & 63) * (1.0f / 32.0f), &s, &co); Dr[c] = (j <= 32 ? co : -s) * sc; }
    for (int kc = 0; kc < 8; ++kc) {
        float a[8];
#pragma unroll
        for (int q = 0; q < 8; ++q) a[q] = 0.f;
#pragma unroll
        for (int c = 0; c < 64; ++c) {
#pragma unroll
            for (int q = 0; q < 8; ++q) a[q] += scr[(kc * 8 + q) * 64 + c] * Dr[c];
        }
        v4u o; o.x = cvtpk(a[0], a[1]); o.y = cvtpk(a[2], a[3]); o.z = cvtpk(a[4], a[5]); o.w = cvtpk(a[6], a[7]);
        *(v4u*)(WT + (size_t)(768 + 64 * grp + j) * DM + k0 + 8 * kc) = o;
    }
    LDS_WAIT(); asm volatile("" ::: "memory");
}
__device__ __forceinline__ void phase_l0a(const Args& A, Frame& F, int li) {
    LAS float* scr = (LAS float*)(F.lds + F.wave * 16384);
    const int gw = F.vcu * NWAVES + F.wave, NGW = F.G * NWAVES, lane = F.lane;
    const float* w_in = A.in[3] + (size_t)li * DM * IN_COLS; const float* g1 = A.in[2] + li * DM;
    const float* w_uq = A.in[15] + (size_t)li * 256 * 384; const float* qg = A.in[14] + li * 256;
    const float* w_ukv = A.in[17] + (size_t)li * 128 * 512; const float* kvg = A.in[16] + li * 128;
    const float* w_br = A.in[19] + (size_t)li * 4 * 256 * DM; const float* w_out = A.in[20] + (size_t)li * DM * DM;
    const float* g2 = A.in[21] + li * DM; const float* w_eg = A.in[23] + (size_t)li * NEXP * DM * DM; const float* w_eu = A.in[24] + (size_t)li * NEXP * DM * DM;
    const float* w_ed = A.in[25] + (size_t)li * NEXP * DM * DM; const float* g3 = A.in[26] + li * DM;
    const float* w_pg = A.in[27] + (size_t)li * DM * DM; const float* w_pp = A.in[28] + (size_t)li * 256 * DM;
    bf16* WIN = (bf16*)(A.ws + WS_WIN); bf16* WUQ = (bf16*)(A.ws + WS_WUQ); bf16* WUKV = (bf16*)(A.ws + WS_WUKV); bf16* WBR = (bf16*)(A.ws + WS_WBR);
    bf16* WOUT = (bf16*)(A.ws + WS_WOUT); bf16* WPG = (bf16*)(A.ws + WS_WPG); bf16* WPP = (bf16*)(A.ws + WS_WPP); bf16* WE1 = (bf16*)(A.ws + WS_WE1); bf16* WE2 = (bf16*)(A.ws + WS_WE2);
    constexpr int I_E = 16 * 32;
    constexpr int I_IN = 16 * 197, I_UQ = 4 * 12, I_UKV = 2 * 16, I_BR = 4 * 4 * 32, I_PP = 4 * 32, I_FN = 64;
    constexpr int NITEMS = NEXP * 3 * I_E + I_IN + I_UQ + I_UKV + I_BR + I_E + I_E + I_PP + I_FN;
    for (int it = gw; it < NITEMS; it += NGW) {
        int r = it;
        if (r < NEXP * 2 * I_E) { const int e = r / (2 * I_E), q = r % (2 * I_E), up = q / I_E, q2 = q % I_E, kb = q2 / 32, nb = q2 % 32, f0 = 32 * nb;
            tr_item((up ? w_eu : w_eg) + (size_t)e * DM * DM, DM, g2, 1.f, WE1 + (size_t)e * 2048 * DM, DM, 64 * kb, f0, 256 * (f0 >> 7) + (f0 & 127) + 128 * up, scr, lane); continue; }
        r -= NEXP * 2 * I_E;
        if (r < NEXP * I_E) { const int e = r / I_E, q2 = r % I_E, kb = q2 / 32, nb = q2 % 32;
            tr_item(w_ed + (size_t)e * DM * DM, DM, nullptr, 1.f, WE2 + (size_t)e * DM * DM, DM, 64 * kb, 32 * nb, 32 * nb, scr, lane); continue; }
        r -= NEXP * I_E;
        if (r < I_IN) { const int kb = r / 197, nb = r % 197, s = 32 * nb; if (s >= 768 && s < 1024) continue; const int d = s < 1440 ? s : s + 96;
            tr_item(w_in, IN_COLS, g1, 1.f, WIN, DM, 64 * kb, s, d, scr, lane); continue; }
        r -= I_IN;
        if (r < I_UQ) { const int kb = r / 12, nb = r % 12; tr_item(w_uq, 384, qg, 0.10206207261596577f * LOG2E, WUQ, 256, 64 * kb, 32 * nb, 32 * nb, scr, lane); continue; }
        r -= I_UQ;
        if (r < I_UKV) { const int kb = r / 16, nb = r % 16; tr_item(w_ukv, 512, kvg, 1.f, WUKV, 256, 64 * kb, 32 * nb, 32 * nb, scr, lane); continue; }
        r -= I_UKV;
        if (r < I_BR) { const int n = r / 128, q2 = r % 128, kb = q2 / 32, nb = q2 % 32; tr_item(w_br + (size_t)n * 256 * DM, DM, nullptr, 1.f, WBR + (size_t)n * DM * 256, 256, 64 * kb, 32 * nb, 32 * nb, scr, lane); continue; }
        r -= I_BR;
        if (r < I_E) { const int kb = r / 32, nb = r % 32; tr_item(w_out, DM, nullptr, 1.f, WOUT, DM, 64 * kb, 32 * nb, 32 * nb, scr, lane); continue; }
        r -= I_E;
        if (r < I_E) { const int kb = r / 32, nb = r % 32; tr_item(w_pg, DM, g3, 1.f, WPG, DM, 64 * kb, 32 * nb, 32 * nb, scr, lane); continue; }
        r -= I_E;
        if (r < I_PP) { const int kb = r / 32, nb = r % 32; tr_item(w_pp, DM, nullptr, 1.f, WPP, 256, 64 * kb, 32 * nb, 32 * nb, scr, lane); continue; }
        r -= I_PP;
        fn_fold_item(w_in, g1, WIN, 64 * (r >> 2), r & 3, scr, lane);
    }
    const int gt = F.vcu * NTHR + F.tid, NGT = F.G * NTHR;
    unsigned zz_ = 0u; asm volatile("" : "+v"(zz_)); const v4u z4 = (v4u){zz_, zz_, zz_, zz_};
    for (int i = gt; i < 96 * 1024 / 8; i += NGT) ((v4u*)(WIN + (size_t)1440 * DM))[i] = z4;
    for (int i = gt; i < 128 * 256 / 8; i += NGT) ((v4u*)(WUQ + (size_t)384 * 256))[i] = z4;
    for (int i = gt; i < 512 * 16; i += NGT) ((v4u*)(WUKV + (size_t)(i >> 4) * 256 + 128))[i & 15] = z4;
    float* st = (float*)(A.ws + WS_STAT);
    if (li > 0) { const f32x4* sp = (const f32x4*)(A.ws + WS_SSP);
        for (int i = gt; i < TOK; i += NGT) { const f32x4 p0 = sp[4 * i], p1 = sp[4 * i + 1], p2 = sp[4 * i + 2], p3 = sp[4 * i + 3];
            st[(size_t)li * TOK + i] = (((p0.x + p0.y) + (p0.z + p0.w)) + ((p1.x + p1.y) + (p1.z + p1.w))) + (((p2.x + p2.y) + (p2.z + p2.w)) + ((p3.x + p3.y) + (p3.z + p3.w))); } }
    const f32x4* p4 = (const f32x4*)(A.in[1] + (size_t)li * TOK * 256); u32x2* pb = (u32x2*)(A.ws + WS_PB);
    for (int i = gt; i < TOK * 256 / 4; i += NGT) { const f32x4 v = p4[i]; pb[i] = (u32x2){cvtpk(v.x, v.y), cvtpk(v.z, v.w)}; }
    __syncthreads();
    {
        LAS float* zs = (LAS float*)F.lds; LAS float* h1s = zs + 8 * 36; LAS float* h2s = h1s + 8 * 64;
        const float* w1 = A.in[7] + li * 33 * 64; const float* b1 = A.in[8] + li * 64; const float* fr = A.in[9] + li * 128;
        const float* w2 = A.in[10] + li * 64 * 64; const float* b2 = A.in[11] + li * 64; const float* w3 = A.in[12] + (size_t)li * 64 * 1024;
        float* KT = (float*)(A.ws + WS_KT);
        const int tid = F.tid;
        for (int u = blockIdx.x; u < 256; u += F.G) {
            const int l0 = 8 * u;
            if (tid < 8 * 33) { const int p = tid / 33, i = tid % 33, l = l0 + p; float v;
                if (i == 0) v = (float)l / 2047.0f;
                else { const int b = (i - 1) & 15; const float band = 1e-4f + (float)b * ((15.0f - 1e-4f) / 15.0f); const float ang = ((6.283185307179586f * (float)l) * band) / 2048.0f;
                    float s, c; sincosf(ang, &s, &c); v = (i <= 16) ? c : -s; }
                zs[p * 36 + i] = v; }
            __syncthreads();
            { const int p = tid >> 6, j = tid & 63; float a = b1[j];
                for (int i = 0; i < 33; ++i) a += zs[p * 36 + i] * w1[i * 64 + j];
                h1s[p * 64 + j] = sinf(fr[j] * a); }
            __syncthreads();
            { const int p = tid >> 6, j = tid & 63; float a = b2[j];
                for (int i = 0; i < 64; ++i) a += h1s[p * 64 + i] * w2[i * 64 + j];
                h2s[p * 64 + j] = sinf(fr[64 + j] * a); }
            __syncthreads();
#pragma unroll
            for (int cc = 0; cc < 2; ++cc) { const int col = tid + 512 * cc; float a[8];
#pragma unroll
                for (int p = 0; p < 8; ++p) a[p] = 0.f;
                for (int i = 0; i < 64; ++i) { const float w = w3[i * 1024 + col];
#pragma unroll
                    for (int p = 0; p < 8; ++p) a[p] += h2s[p * 64 + i] * w; }
                const int o = col >> 9, dir = (col >> 8) & 1, c = col & 255;
                const float mind = -3.0701134573253945f, maxd = -15.350567286626973f;
                const float ad = fabsf(mind + (float)c * ((maxd - mind) / 255.0f));
                float* kt = KT + (size_t)(o * 256 + c) * 4096;
#pragma unroll
                for (int p = 0; p < 8; ++p) { const int l = l0 + p; const float wv = a[p] * __expf(-((float)l / 2047.0f) * ad);
                    if (dir == 0) kt[l] = wv; else if (l > 0) kt[4096 - l] = wv; }
                if (u == 0 && dir == 0) kt[2048] = 0.f; }
            __syncthreads();
        }
    }
}
__device__ __forceinline__ void filter_fft(const Args& A, Frame& F) {
    LAS f32x2* buf = (LAS f32x2*)(F.lds + FFT_BUF_OFF); const LAS f32x2* tw = (const LAS f32x2*)(F.lds + FFT_TW_OFF); LAS float* red = (LAS float*)(F.lds + FFT_STAGE_OFF);
    const float* KT = (const float*)(A.ws + WS_KT); f32x2* KF = (f32x2*)(A.ws + WS_KF);
    fft_init_tw(A, F);
    for (int u = blockIdx.x; u < 512; u += F.G) {
        const float* kt = KT + (size_t)u * 4096; float v[8]; float s = 0.f;
#pragma unroll
        for (int k = 0; k < 8; ++k) { v[k] = kt[F.tid + 512 * k]; s += v[k] * v[k]; }
        s = wave_sum(s);
        if (F.lane == 0) red[F.wave] = s;
        __syncthreads();
        float tot = 0.f;
#pragma unroll
        for (int w = 0; w < 8; ++w) tot += red[w];
        const float sc = rsqrtf(tot + EPS) * (1.0f / 4096.0f);
#pragma unroll
        for (int k = 0; k < 8; ++k) buf[fpad(F.tid + 512 * k)] = (f32x2){v[k] * sc, 0.f};
        __syncthreads();
        fft_fwd(buf, tw, F.tid);
#pragma unroll
        for (int k = 0; k < 8; ++k) KF[(size_t)u * 4096 + F.tid + 512 * k] = buf[fpad(F.tid + 512 * k)];
        __syncthreads();
    }
}
#ifndef MK_DROP
#define MK_DROP 0
#endif

typedef const f32x4 (&AccRef)[2][2][4][2];
__device__ __forceinline__ void st_bf16x4(bf16* p, f32x4 v) { *(u32x2*)p = (u32x2){cvtpk(v.x, v.y), cvtpk(v.z, v.w)}; }
__device__ __forceinline__ f32x4 ld_bf16x4(const bf16* p) { const u32x2 w = *(const u32x2*)p;
    return (f32x4){__builtin_bit_cast(float, w.x << 16), __builtin_bit_cast(float, w.x & 0xffff0000u), __builtin_bit_cast(float, w.y << 16), __builtin_bit_cast(float, w.y & 0xffff0000u)}; }

struct EpiWin {
    static constexpr bool PERM = false, AFTER_DRAIN = false;
    const float* ss1; const float* bgate; unsigned char* ws;
    __device__ __forceinline__ void operator()(AccRef acc, const pg8::Unit& u, int wr, int wc, int fr, int fq) const {
        const int pn = u.pn, row0 = u.pm * 256 + wr * 64 + fr;
        float rs[2][4];
#pragma unroll
        for (int ai = 0; ai < 2; ++ai)
#pragma unroll
            for (int m = 0; m < 4; ++m) rs[ai][m] = rsqrtf(ss1[row0 + ai * 128 + m * 16] * (1.0f / 1024.0f) + EPS);
        if (pn >= 9) {
            bf16* G = (bf16*)(ws + WS_GATES); const int cg0 = 256 * (pn - 9) + 32 * wc + 4 * fq;
#pragma unroll
            for (int bj = 0; bj < 2; ++bj)
#pragma unroll
                for (int n = 0; n < 2; ++n) { const int cg = cg0 + 128 * bj + 16 * n; const f32x4 bv = *(const f32x4*)(bgate + cg);
#pragma unroll
                    for (int ai = 0; ai < 2; ++ai)
#pragma unroll
                        for (int m = 0; m < 4; ++m) { const f32x4 a = acc[ai][bj][m][n] * rs[ai][m] + bv;
                            st_bf16x4(G + (size_t)(row0 + ai * 128 + m * 16) * 4096 + cg, (f32x4){sigmoidf_(a.x), sigmoidf_(a.y), sigmoidf_(a.z), sigmoidf_(a.w)}); } }
        } else if (pn <= 3 || pn == 8) {
            bf16* D; int NC, ct0;
            if (pn <= 2) { D = (bf16*)(ws + WS_UHYT); NC = 768; ct0 = 256 * pn; } else if (pn == 3) { D = (bf16*)(ws + WS_UFNT); NC = 256; ct0 = 0; } else { D = (bf16*)(ws + WS_NAVT); NC = 256; ct0 = 0; }
            const int b = row0 >> 11, l0 = row0 & 2047;
#pragma unroll
            for (int bj = 0; bj < 2; ++bj)
#pragma unroll
                for (int n = 0; n < 2; ++n) { const int ct = ct0 + 128 * bj + 32 * wc + 16 * n + 4 * fq; bf16* dp = D + ((size_t)(b * NC + ct)) * 2048 + l0;
#pragma unroll
                    for (int ai = 0; ai < 2; ++ai)
#pragma unroll
                        for (int m = 0; m < 4; ++m) { const f32x4 a = acc[ai][bj][m][n] * rs[ai][m]; bf16* q = dp + ai * 128 + m * 16;
                            const unsigned w0 = cvtpk(a.x, a.y), w1 = cvtpk(a.z, a.w);
                            q[0] = (bf16)w0; q[2048] = (bf16)(w0 >> 16); q[4096] = (bf16)w1; q[6144] = (bf16)(w1 >> 16); } }
        } else {
            bf16* D = (bf16*)(ws + (pn == 4 ? WS_CQ : pn == 5 ? WS_CKV : pn == 6 ? WS_NAQ : WS_NAK));
            const float csc = (pn == 6) ? 0.125f * LOG2E : 1.0f;
            float* ssx = (float*)(ws + WS_STAT) + (size_t)(pn == 4 ? 7 : 11) * TOK;
#pragma unroll
            for (int ai = 0; ai < 2; ++ai)
#pragma unroll
                for (int m = 0; m < 4; ++m) { const int row = row0 + ai * 128 + m * 16; float s = 0.f;
#pragma unroll
                    for (int bj = 0; bj < 2; ++bj)
#pragma unroll
                        for (int n = 0; n < 2; ++n) { const f32x4 a = acc[ai][bj][m][n] * (rs[ai][m] * csc);
                            st_bf16x4(D + (size_t)row * 256 + 128 * bj + 32 * wc + 16 * n + 4 * fq, a);
                            if (pn == 4 || (pn == 5 && bj == 0)) s += (a.x * a.x + a.y * a.y) + (a.z * a.z + a.w * a.w); }
                    if (pn == 4 || pn == 5) { s += __shfl_xor(s, 16); s += __shfl_xor(s, 32); if (fq == 0) ssx[(size_t)row * 4 + wc] = s; }
                    if (pn == 5 && wc == 0) {
                        const f32x4 x1 = acc[ai][1][m][0] * rs[ai][m], x2 = acc[ai][1][m][1] * rs[ai][m]; const float* rc = (const float*)(ws + WS_ROPE) + (row & 2047) * 16 + 4 * fq;
                        const f32x4 cs = *(const f32x4*)rc, sn = *(const f32x4*)(rc + SEQ * 16); const f32x4 o1 = x1 * cs - x2 * sn, o2 = x2 * cs + x1 * sn;
                        bf16* kf = (bf16*)(ws + WS_KFULL) + (size_t)row * 384 + 64 + 4 * fq;
#pragma unroll
                        for (int h = 0; h < 4; ++h) { st_bf16x4(kf + h * 96, o1); st_bf16x4(kf + h * 96 + 16, o2); }
                    } }
        }
    }
};
struct EpiQ {
    static constexpr bool PERM = false, AFTER_DRAIN = false;
    unsigned char* ws;
    __device__ __forceinline__ void operator()(AccRef acc, const pg8::Unit& u, int wr, int wc, int fr, int fq) const {
        const float* ssq = (const float*)(ws + WS_STAT) + (size_t)7 * TOK; bf16* Q = (bf16*)(ws + WS_Q);
        const int row0 = u.pm * 256 + wr * 64 + fr;
#pragma unroll
        for (int bj = 0; bj < 2; ++bj) { const int gb = 256 * u.pn + 128 * bj + 32 * wc; if (gb >= 384) continue; const bool rope = (gb % 96) == 64;
#pragma unroll
            for (int ai = 0; ai < 2; ++ai)
#pragma unroll
                for (int m = 0; m < 4; ++m) { const int row = row0 + ai * 128 + m * 16; const f32x4 pq = *(const f32x4*)(ssq + (size_t)row * 4); const float r = rsqrtf(((pq.x + pq.y) + (pq.z + pq.w)) * (1.0f / 256.0f) + EPS);
                    f32x4 o1 = acc[ai][bj][m][0] * r, o2 = acc[ai][bj][m][1] * r;
                    if (rope) { const f32x4 x1 = o1, x2 = o2; const float* rc = (const float*)(ws + WS_ROPE) + (row & 2047) * 16 + 4 * fq;
                        const f32x4 cs = *(const f32x4*)rc, sn = *(const f32x4*)(rc + SEQ * 16); o1 = x1 * cs - x2 * sn; o2 = x2 * cs + x1 * sn; }
                    st_bf16x4(Q + (size_t)row * 384 + gb + 4 * fq, o1); st_bf16x4(Q + (size_t)row * 384 + gb + 16 + 4 * fq, o2); asm volatile("" ::: "memory"); } }
    }
};
struct EpiKV {
    static constexpr bool PERM = false, AFTER_DRAIN = false;
    unsigned char* ws;
    __device__ __forceinline__ void operator()(AccRef acc, const pg8::Unit& u, int wr, int wc, int fr, int fq) const {
        const float* sskv = (const float*)(ws + WS_STAT) + (size_t)11 * TOK; bf16* KFU = (bf16*)(ws + WS_KFULL); bf16* VT = (bf16*)(ws + WS_VT);
        const int row0 = u.pm * 256 + wr * 64 + fr;
#pragma unroll
        for (int ai = 0; ai < 2; ++ai)
#pragma unroll
            for (int m = 0; m < 4; ++m) { const int row = row0 + ai * 128 + m * 16; const f32x4 pq = *(const f32x4*)(sskv + (size_t)row * 4); const float r = rsqrtf(((pq.x + pq.y) + (pq.z + pq.w)) * (1.0f / 128.0f) + EPS); const int b = row >> 11, l = row & 2047;
#pragma unroll
                for (int bj = 0; bj < 2; ++bj) { const int h = 2 * u.pn + bj;
#pragma unroll
                    for (int n = 0; n < 2; ++n) { const f32x4 a = acc[ai][bj][m][n] * r; const int within = 32 * wc + 16 * n + 4 * fq;
                        if (wc < 2) st_bf16x4(KFU + (size_t)row * 384 + h * 96 + within, a);
                        else { bf16* q = VT + ((size_t)((b * 4 + h) * 64 + (within - 64))) * 2048 + l; const unsigned w0 = cvtpk(a.x, a.y), w1 = cvtpk(a.z, a.w);
                            q[0] = (bf16)w0; q[2048] = (bf16)(w0 >> 16); q[4096] = (bf16)w1; q[6144] = (bf16)(w1 >> 16); } } }
                asm volatile("" ::: "memory"); }
    }
};
struct EpiBranch {
    static constexpr bool PERM = false, AFTER_DRAIN = false;
    unsigned char* ws; int n;
    __device__ __forceinline__ void operator()(AccRef acc, const pg8::Unit& u, int wr, int wc, int fr, int fq) const {
        const bf16* G = (const bf16*)(ws + WS_GATES) + n * 1024; float* MP = (float*)(ws + WS_MPART); bf16* MG = (bf16*)(ws + WS_MERGED);
        const int row0 = u.pm * 256 + wr * 64 + fr, col0 = u.pn * 256 + 32 * wc + 4 * fq;
#pragma unroll
        for (int ai = 0; ai < 2; ++ai)
#pragma unroll
            for (int m = 0; m < 4; ++m) { const int row = row0 + ai * 128 + m * 16;
#pragma unroll
                for (int bj = 0; bj < 2; ++bj)
#pragma unroll
                    for (int nn = 0; nn < 2; ++nn) { const int col = col0 + 128 * bj + 16 * nn; const f32x4 g = ld_bf16x4(G + (size_t)row * 4096 + col);
                        f32x4 v = acc[ai][bj][m][nn] * g;
                        if ((MK_DROP >> n) & 1) v = v * 0.f;
                        if (n > 0) v += *(const f32x4*)(MP + (size_t)row * DM + col);
                        if (n < 3) *(f32x4*)(MP + (size_t)row * DM + col) = v; else st_bf16x4(MG + (size_t)row * DM + col, v); }
                asm volatile("" ::: "memory"); }
    }
};
struct EpiResid {
    static constexpr bool PERM = false, AFTER_DRAIN = false;
    unsigned char* ws; float* xo;
    __device__ __forceinline__ void operator()(AccRef acc, const pg8::Unit& u, int wr, int wc, int fr, int fq) const {
        bf16* XB = (bf16*)(ws + WS_XB);
        const int row0 = u.pm * 256 + wr * 64 + fr, col0 = u.pn * 256 + 32 * wc + 4 * fq;
#pragma unroll
        for (int ai = 0; ai < 2; ++ai)
#pragma unroll
            for (int m = 0; m < 4; ++m) { const int row = row0 + ai * 128 + m * 16;
#pragma unroll
                for (int bj = 0; bj < 2; ++bj)
#pragma unroll
                    for (int nn = 0; nn < 2; ++nn) { const size_t o = (size_t)row * DM + col0 + 128 * bj + 16 * nn; const f32x4 v = *(const f32x4*)(xo + o) + acc[ai][bj][m][nn];
                        *(f32x4*)(xo + o) = v; st_bf16x4(XB + o, v); }
                asm volatile("" ::: "memory"); }
    }
};
struct EpiSwiglu {
    static constexpr bool PERM = false, AFTER_DRAIN = false;
    unsigned char* ws;
    __device__ __forceinline__ void operator()(AccRef acc, const pg8::Unit& u, int wr, int wc, int fr, int fq) const {
        const float* rsc = (const float*)(ws + WS_SEL); bf16* HB = (bf16*)(ws + WS_HB);
        const int row0 = u.pm * 256 + wr * 64 + fr, col0 = (u.pn & 7) * 128 + 32 * wc + 4 * fq;
#pragma unroll
        for (int ai = 0; ai < 2; ++ai)
#pragma unroll
            for (int m = 0; m < 4; ++m) { const int row = row0 + ai * 128 + m * 16; const float r = rsc[row];
#pragma unroll
                for (int nn = 0; nn < 2; ++nn) { const f32x4 g = acc[ai][0][m][nn] * r, up = acc[ai][1][m][nn] * r; f32x4 h;
#pragma unroll
                    for (int j = 0; j < 4; ++j) h[j] = g[j] * sigmoidf_(g[j]) * up[j];
                    st_bf16x4(HB + (size_t)row * DM + col0 + 16 * nn, h); } }
    }
};
struct EpiDown {
    static constexpr bool PERM = false, AFTER_DRAIN = false;
    unsigned char* ws;
    __device__ __forceinline__ void operator()(AccRef acc, const pg8::Unit& u, int wr, int wc, int fr, int fq) const {
        const float* aff = (const float*)(ws + WS_SEL) + NSLOT; bf16* YE = (bf16*)(ws + WS_XE);
        const int row0 = u.pm * 256 + wr * 64 + fr, col0 = (u.pn & 3) * 256 + 32 * wc + 4 * fq;
#pragma unroll
        for (int ai = 0; ai < 2; ++ai)
#pragma unroll
            for (int m = 0; m < 4; ++m) { const int row = row0 + ai * 128 + m * 16; const float r = 1.0f; (void)aff;
#pragma unroll
                for (int bj = 0; bj < 2; ++bj)
#pragma unroll
                    for (int nn = 0; nn < 2; ++nn) st_bf16x4(YE + (size_t)row * DM + col0 + 128 * bj + 16 * nn, acc[ai][bj][m][nn] * r); }
    }
};
struct EpiPP {
    static constexpr bool PERM = false, AFTER_DRAIN = false;
    unsigned char* ws;
    __device__ __forceinline__ void operator()(AccRef acc, const pg8::Unit& u, int wr, int wc, int fr, int fq) const {
        bf16* PP = (bf16*)(ws + WS_MERGED);
        const int row0 = u.pm * 256 + wr * 64 + fr, col0 = u.pn * 256 + 32 * wc + 4 * fq;
#pragma unroll
        for (int ai = 0; ai < 2; ++ai)
#pragma unroll
            for (int m = 0; m < 4; ++m) { const int row = row0 + ai * 128 + m * 16;
#pragma unroll
                for (int bj = 0; bj < 2; ++bj)
#pragma unroll
                    for (int nn = 0; nn < 2; ++nn) st_bf16x4(PP + (size_t)row * DM + col0 + 128 * bj + 16 * nn, acc[ai][bj][m][nn]); }
    }
};
struct EpiPle {
    static constexpr bool PERM = false, AFTER_DRAIN = false;
    unsigned char* ws; float* xo; float* ssn;
    __device__ __forceinline__ void operator()(AccRef acc, const pg8::Unit& u, int wr, int wc, int fr, int fq) const {
        const float* ir3 = (const float*)(ws + WS_STAT) + (size_t)6 * TOK; const bf16* PP = (const bf16*)(ws + WS_MERGED); bf16* XB = (bf16*)(ws + WS_XB);
        const int row0 = u.pm * 256 + wr * 64 + fr, col0 = u.pn * 256 + 32 * wc + 4 * fq;
#pragma unroll
        for (int ai = 0; ai < 2; ++ai)
#pragma unroll
            for (int m = 0; m < 4; ++m) { const int row = row0 + ai * 128 + m * 16; const float r = ir3[row]; float s = 0.f;
#pragma unroll
                for (int bj = 0; bj < 2; ++bj)
#pragma unroll
                    for (int nn = 0; nn < 2; ++nn) { const size_t o = (size_t)row * DM + col0 + 128 * bj + 16 * nn; const f32x4 a = acc[ai][bj][m][nn] * r, pp = ld_bf16x4(PP + o); f32x4 v = *(const f32x4*)(xo + o);
#pragma unroll
                        for (int j = 0; j < 4; ++j) v[j] += ((MK_DROP >> 5) & 1) ? 0.f : sigmoidf_(a[j]) * pp[j];
                        *(f32x4*)(xo + o) = v; st_bf16x4(XB + o, v); s += (v.x * v.x + v.y * v.y) + (v.z * v.z + v.w * v.w); asm volatile("" ::: "memory"); }
                s += __shfl_xor(s, 16); s += __shfl_xor(s, 32); if (fq == 0) ssn[(size_t)row * 16 + u.pn * 4 + wc] = s;
                asm volatile("" ::: "memory"); }
    }
};
struct MoeOrder {
    int G, c, npn, total;
    __device__ bool next(int i, pg8::Unit& u) const { const int L = i * G + c; if (L >= total) return false; const int upe = 8 * npn, e = L / upe, rem = L % upe; u.pm = e * 8 + rem / npn; u.pn = e * npn + rem % npn; return true; }
    __device__ __forceinline__ void a_ready(const pg8::Unit&) const {}
    __device__ __forceinline__ void done(const pg8::Unit&) const {}
};

__device__ __forceinline__ float hy_uc(const bf16* up, int l, float w0, float w1, float w2, float bb) {
    const float a = l > 0 ? bf2f(up[l - 1]) : 0.f, b = bf2f(up[l]), c = l < SEQ - 1 ? bf2f(up[l + 1]) : 0.f;
    return w0 * a + w1 * b + w2 * c + bb;
}
__device__ __forceinline__ void hyena_phase(const Args& A, Frame& F, int li) {
    LAS f32x2* buf = (LAS f32x2*)(F.lds + FFT_BUF_OFF); const LAS f32x2* tw = (const LAS f32x2*)(F.lds + FFT_TW_OFF); LAS bf16* stg = (LAS bf16*)(F.lds + FFT_STAGE_OFF);
    const bf16* U = (const bf16*)(A.ws + WS_UHYT); const f32x2* KF = (const f32x2*)(A.ws + WS_KF); bf16* Y = (bf16*)(A.ws + WS_YHY);
    const float* cw = A.in[5] + li * 3 * 768; const float* cb = A.in[6] + li * 768; const float* skip = A.in[13] + li * 512;
    const int tid = F.tid; float zf = 0.f; asm volatile("" : "+v"(zf));
    for (int unit = blockIdx.x; unit < 256; unit += F.G) {
        const int bp = unit >> 6, c0 = (unit & 63) * 4, b0 = 2 * bp;
        for (int ci = 0; ci < 4; ++ci) {
            const int c = c0 + ci;
            float v[2][4], x1[2][4], x2[2][4];
            {
                const float a0 = cw[c], a1 = cw[768 + c], a2 = cw[1536 + c], ab = cb[c];
                const float d0 = cw[256 + c], d1 = cw[768 + 256 + c], d2 = cw[1536 + 256 + c], db = cb[256 + c];
                const float e0 = cw[512 + c], e1 = cw[768 + 512 + c], e2 = cw[1536 + 512 + c], eb = cb[512 + c];
#pragma unroll
                for (int bb = 0; bb < 2; ++bb) { const bf16* ub = U + (size_t)((b0 + bb) * 768) * SEQ;
#pragma unroll
                    for (int k = 0; k < 4; ++k) { const int l = tid + 512 * k;
                        x1[bb][k] = hy_uc(ub + (size_t)c * SEQ, l, a0, a1, a2, ab);
                        x2[bb][k] = hy_uc(ub + (size_t)(256 + c) * SEQ, l, d0, d1, d2, db);
                        v[bb][k] = hy_uc(ub + (size_t)(512 + c) * SEQ, l, e0, e1, e2, eb); } }
            }
#pragma unroll
            for (int k = 0; k < 4; ++k) { const int l = tid + 512 * k; buf[fpad(l)] = (f32x2){v[0][k], v[1][k]}; buf[fpad(2048 + l)] = (f32x2){zf, zf}; }
            __syncthreads();
            fft_fwd(buf, tw, tid);
            { const f32x2* kf = KF + (size_t)c * 4096;
#pragma unroll
                for (int k = 0; k < 8; ++k) { const int p = tid + 512 * k; buf[fpad(p)] = cmul(buf[fpad(p)], kf[p]); } }
            __syncthreads();
            fft_inv(buf, tw, tid);
            float z[2][4]; const float s0 = skip[c], s1 = skip[256 + c];
#pragma unroll
            for (int k = 0; k < 4; ++k) { const int l = tid + 512 * k; const f32x2 y = buf[fpad(l)];
                z[0][k] = x1[0][k] * (y.x + v[0][k] * s0); z[1][k] = x1[1][k] * (y.y + v[1][k] * s0);
                buf[fpad(l)] = (f32x2){z[0][k], z[1][k]}; buf[fpad(2048 + l)] = (f32x2){zf, zf}; }
            __syncthreads();
            fft_fwd(buf, tw, tid);
            { const f32x2* kf = KF + (size_t)(256 + c) * 4096;
#pragma unroll
                for (int k = 0; k < 8; ++k) { const int p = tid + 512 * k; buf[fpad(p)] = cmul(buf[fpad(p)], kf[p]); } }
            __syncthreads();
            fft_inv(buf, tw, tid);
#pragma unroll
            for (int k = 0; k < 4; ++k) { const int l = tid + 512 * k; const f32x2 y = buf[fpad(l)];
                const float o0 = x2[0][k] * (y.x + z[0][k] * s1), o1 = x2[1][k] * (y.y + z[1][k] * s1);
                const unsigned w = cvtpk(o0, o1);
                stg[(size_t)l * 4 + ci] = (bf16)w; stg[(size_t)(2048 + l) * 4 + ci] = (bf16)(w >> 16); }
            __syncthreads();
        }
#pragma unroll
        for (int k = 0; k < 8; ++k) { const int t = tid + 512 * k, bb = t >> 11, l = t & 2047;
            *(u32x2*)(Y + (size_t)((b0 + bb) * SEQ + l) * 256 + c0) = *(const LAS u32x2*)(stg + (size_t)t * 4); }
        __syncthreads();
    }
}
__device__ __forceinline__ void fnet_phase(const Args& A, Frame& F) {
    LAS f32x2* buf = (LAS f32x2*)(F.lds + FFT_BUF_OFF); const LAS f32x2* tw = (const LAS f32x2*)(F.lds + FFT_TW_OFF); LAS bf16* stg = (LAS bf16*)(F.lds + FFT_STAGE_OFF);
    const bf16* U = (const bf16*)(A.ws + WS_UFNT); bf16* Y = (bf16*)(A.ws + WS_YFN);
    const int tid = F.tid; float zf = 0.f; asm volatile("" : "+v"(zf));
    for (int unit = blockIdx.x; unit < 128; unit += F.G) {
        const int b = unit >> 4, g = (unit >> 2) & 3, ch = unit & 3;
        for (int fi = 0; fi < 8; ++fi) {
            const int m = 8 * ch + fi;
            const bf16* ure = U + (size_t)(b * 256 + 64 * g + m) * SEQ; const bf16* uim = U + (size_t)(b * 256 + 64 * g + 32 + m) * SEQ;
#pragma unroll
            for (int k = 0; k < 4; ++k) { const int l = tid + 512 * k; buf[fpad(l)] = (f32x2){bf2f(ure[l]), bf2f(uim[l])}; buf[fpad(2048 + l)] = (f32x2){zf, zf}; }
            __syncthreads();
            fft_fwd(buf, tw, tid);
#pragma unroll
            for (int k = 0; k < 4; ++k) { const int kk = tid + 512 * k; const f32x2 z1 = buf[fpad(digrev(2 * kk))], z2 = buf[fpad(digrev((2 * (2048 - kk)) & 4095))];
                float ya, yb;
                if (m == 0) { ya = 0.5f * (z1.x + z2.x); yb = 0.5f * (z1.y + z2.y); } else { ya = z1.x; yb = z2.x; }
                const unsigned w = cvtpk(ya, yb);
                stg[(size_t)kk * 16 + fi] = (bf16)w; stg[(size_t)kk * 16 + 8 + fi] = (bf16)(w >> 16); }
            __syncthreads();
        }
        for (int i = tid; i < 2048 * 16; i += NTHR) { const int kk = i >> 4, slot = i & 15, fi = slot & 7, m = 8 * ch + fi;
            const int col = slot < 8 ? m : (m == 0 ? 32 : 64 - m);
            Y[(size_t)(b * SEQ + kk) * 256 + 64 * g + col] = stg[i]; }
        __syncthreads();
    }
}
__device__ __forceinline__ void softmax_step(f32x16 (&S)[2], float& mrun, float& lrun, f32x16& o0, f32x16& o1, bf16x8 (&pf)[2][2]) {
    float mx = S[0][0];
#pragma unroll
    for (int kb = 0; kb < 2; ++kb)
#pragma unroll
        for (int r = 0; r < 16; ++r) mx = fmaxf(mx, S[kb][r]);
    mx = fmaxf(mx, __shfl_xor(mx, 32));
    const float mnew = fmaxf(mrun, mx), alpha = fast_exp2(mrun - mnew); mrun = mnew;
    float ls = 0.f;
#pragma unroll
    for (int kb = 0; kb < 2; ++kb)
#pragma unroll
        for (int r = 0; r < 16; ++r) { const float p = fast_exp2(S[kb][r] - mnew); S[kb][r] = p; ls += p; }
    lrun = lrun * alpha + ls;
    o0 *= alpha; o1 *= alpha;
#pragma unroll
    for (int kb = 0; kb < 2; ++kb)
#pragma unroll
        for (int s2 = 0; s2 < 2; ++s2) { v4u w; w.x = cvtpk(S[kb][8 * s2 + 0], S[kb][8 * s2 + 1]); w.y = cvtpk(S[kb][8 * s2 + 2], S[kb][8 * s2 + 3]);
            w.z = cvtpk(S[kb][8 * s2 + 4], S[kb][8 * s2 + 5]); w.w = cvtpk(S[kb][8 * s2 + 6], S[kb][8 * s2 + 7]); pf[kb][s2] = __builtin_bit_cast(bf16x8, w); }
}
__device__ __forceinline__ void attn_store(bf16* yrow, const f32x16& o0, const f32x16& o1, float lrun, int hh) {
    const float lt = lrun + __shfl_xor(lrun, 32), inv = 1.0f / lt;
#pragma unroll
    for (int g = 0; g < 4; ++g) {
        st_bf16x4(yrow + 8 * g + 4 * hh, (f32x4){o0[4 * g] * inv, o0[4 * g + 1] * inv, o0[4 * g + 2] * inv, o0[4 * g + 3] * inv});
        st_bf16x4(yrow + 32 + 8 * g + 4 * hh, (f32x4){o1[4 * g] * inv, o1[4 * g + 1] * inv, o1[4 * g + 2] * inv, o1[4 * g + 3] * inv}); }
}
__device__ __forceinline__ void na_phase(const Args& A, Frame& F, int li) {
    LAS float* rpbL = (LAS float*)F.lds;
    const float* rpb = A.in[18] + li * 4 * 15 * 31;
    for (int i = F.tid; i < 4 * 15 * 31; i += NTHR) rpbL[i] = rpb[i] * LOG2E;
    __syncthreads();
    const bf16* NQ = (const bf16*)(A.ws + WS_NAQ); const bf16* NK = (const bf16*)(A.ws + WS_NAK); const bf16* NVT = (const bf16*)(A.ws + WS_NAVT); bf16* Y = (bf16*)(A.ws + WS_YNA);
    const int gw = F.vcu * NWAVES + F.wave, NGW = F.G * NWAVES, lane = F.lane, hh = lane >> 5, lq = lane & 31;
    for (int wu = gw; wu < 2048; wu += NGW) {
        const int b = wu >> 8, h = (wu >> 6) & 3, r = (wu >> 1) & 31, half = wu & 1;
        const int qtok = b * SEQ + r * 64 + half * 32 + lq, c = half * 32 + lq, cs = min(max(c - 8, 0), 48), rs = min(max(r - 4, 0), 24);
        bf16x8 qf[4];
#pragma unroll
        for (int ks = 0; ks < 4; ++ks) qf[ks] = *(const bf16x8*)(NQ + (size_t)qtok * 256 + h * 64 + 16 * ks + 8 * hh);
        f32x16 o0, o1;
#pragma unroll
        for (int i = 0; i < 16; ++i) { o0[i] = 0.f; o1[i] = 0.f; }
        float mrun = -1e30f, lrun = 0.f;
        for (int step = 0; step < 8; ++step) {
            const int krow = rs + step, dr = krow - r + 7;
            f32x16 S[2];
#pragma unroll
            for (int kb = 0; kb < 2; ++kb) { f32x16 s;
#pragma unroll
                for (int i = 0; i < 16; ++i) s[i] = 0.f;
                const bf16* kp = NK + (size_t)(b * SEQ + krow * 64 + kb * 32 + lq) * 256 + h * 64 + 8 * hh;
#pragma unroll
                for (int ks = 0; ks < 4; ++ks) s = __builtin_amdgcn_mfma_f32_32x32x16_bf16(*(const bf16x8*)(kp + 16 * ks), qf[ks], s, 0, 0, 0);
#pragma unroll
                for (int rr = 0; rr < 16; ++rr) { const int kc = kb * 32 + (rr & 3) + 8 * (rr >> 2) + 4 * hh; const bool ok = (kc >= cs) && (kc < cs + 16);
                    const int dc = min(max(kc - c + 15, 0), 30); const float bias = rpbL[(h * 15 + dr) * 31 + dc];
                    s[rr] = ok ? s[rr] + bias : -1e30f; }
                S[kb] = s; }
            bf16x8 pf[2][2];
            softmax_step(S, mrun, lrun, o0, o1, pf);
#pragma unroll
            for (int kb = 0; kb < 2; ++kb)
#pragma unroll
                for (int s2 = 0; s2 < 2; ++s2) {
#pragma unroll
                    for (int db = 0; db < 2; ++db) { const bf16* vp = NVT + (size_t)(b * 256 + h * 64 + db * 32 + lq) * SEQ + krow * 64 + kb * 32 + 16 * s2 + 4 * hh;
                        const u32x2 lo = *(const u32x2*)vp, hi = *(const u32x2*)(vp + 8); const bf16x8 va = __builtin_bit_cast(bf16x8, (v4u){lo.x, lo.y, hi.x, hi.y});
                        if (db == 0) o0 = __builtin_amdgcn_mfma_f32_32x32x16_bf16(va, pf[kb][s2], o0, 0, 0, 0); else o1 = __builtin_amdgcn_mfma_f32_32x32x16_bf16(va, pf[kb][s2], o1, 0, 0, 0); } }
        }
        attn_store(Y + (size_t)qtok * 256 + h * 64, o0, o1, lrun, hh);
    }
}
constexpr int AT_KP = 208, AT_VP = 136, AT_KB = 64 * AT_KP, AT_VB = 64 * AT_VP, AT_BUF = AT_KB + AT_VB;
__device__ __forceinline__ void mla_attn_phase(const Args& A, Frame& F) {
    const bf16* Q = (const bf16*)(A.ws + WS_Q); const bf16* KFU = (const bf16*)(A.ws + WS_KFULL); const bf16* VT = (const bf16*)(A.ws + WS_VT); bf16* Y = (bf16*)(A.ws + WS_YMLA);
    const int tid = F.tid, lane = F.lane, hh = lane >> 5, lq = lane & 31;
    for (int unit = F.vcu; unit < 256; unit += F.G) {
        const int b = unit >> 5, h = (unit >> 3) & 3, qb = unit & 7;
        const int qtok = b * SEQ + qb * 256 + F.wave * 32 + lq;
        bf16x8 qf[6];
#pragma unroll
        for (int ks = 0; ks < 6; ++ks) qf[ks] = *(const bf16x8*)(Q + (size_t)qtok * 384 + h * 96 + 16 * ks + 8 * hh);
        const bf16* Kg = KFU + (size_t)(b * SEQ) * 384 + h * 96; const bf16* Vg = VT + (size_t)((b * 4 + h) * 64) * SEQ;
        const int kc0 = tid, kc1 = tid + 512; const bool k1ok = kc1 < 768;
        const int kk0 = kc0 / 12, kch0 = kc0 % 12, kk1 = k1ok ? kc1 / 12 : 0, kch1 = k1ok ? kc1 % 12 : 0, vd = tid >> 3, vch = tid & 7;
        v4u rk0, rk1, rv;
#define AT_LOAD(t) do { const int key0 = (t) * 64; rk0 = *(const v4u*)(Kg + (size_t)(key0 + kk0) * 384 + kch0 * 8); if (k1ok) rk1 = *(const v4u*)(Kg + (size_t)(key0 + kk1) * 384 + kch1 * 8); \
        rv = *(const v4u*)(Vg + (size_t)vd * SEQ + key0 + vch * 8); } while (0)
#define AT_WRITE(bufi) do { LAS unsigned char* kb_ = F.lds + (bufi) * AT_BUF; *(LAS v4u*)(kb_ + kk0 * AT_KP + kch0 * 16) = rk0; if (k1ok) *(LAS v4u*)(kb_ + kk1 * AT_KP + kch1 * 16) = rk1; \
        LAS unsigned char* vb_ = kb_ + AT_KB + vd * AT_VP + vch * 16; *(LAS u32x2*)vb_ = (u32x2){rv.x, rv.y}; *(LAS u32x2*)(vb_ + 8) = (u32x2){rv.z, rv.w}; } while (0)
        f32x16 o0, o1;
#pragma unroll
        for (int i = 0; i < 16; ++i) { o0[i] = 0.f; o1[i] = 0.f; }
        float mrun = -1e30f, lrun = 0.f;
        AT_LOAD(0); AT_WRITE(0);
        __syncthreads();
        for (int t = 0; t < 32; ++t) {
            if (t + 1 < 32) AT_LOAD(t + 1);
            const LAS unsigned char* kbuf = F.lds + (t & 1) * AT_BUF; const LAS unsigned char* vbuf = kbuf + AT_KB;
            f32x16 S[2];
#pragma unroll
            for (int kb = 0; kb < 2; ++kb) { f32x16 s;
#pragma unroll
                for (int i = 0; i < 16; ++i) s[i] = 0.f;
#pragma unroll
                for (int ks = 0; ks < 6; ++ks) s = __builtin_amdgcn_mfma_f32_32x32x16_bf16(*(const LAS bf16x8*)(kbuf + (kb * 32 + lq) * AT_KP + (16 * ks + 8 * hh) * 2), qf[ks], s, 0, 0, 0);
                S[kb] = s; }
            bf16x8 pf[2][2];
            softmax_step(S, mrun, lrun, o0, o1, pf);
#pragma unroll
            for (int kb = 0; kb < 2; ++kb)
#pragma unroll
                for (int s2 = 0; s2 < 2; ++s2) {
#pragma unroll
                    for (int db = 0; db < 2; ++db) { const LAS unsigned char* vp = vbuf + (db * 32 + lq) * AT_VP + (kb * 32 + 16 * s2 + 4 * hh) * 2;
                        const u32x2 lo = *(const LAS u32x2*)vp, hi = *(const LAS u32x2*)(vp + 16); const bf16x8 va = __builtin_bit_cast(bf16x8, (v4u){lo.x, lo.y, hi.x, hi.y});
                        if (db == 0) o0 = __builtin_amdgcn_mfma_f32_32x32x16_bf16(va, pf[kb][s2], o0, 0, 0, 0); else o1 = __builtin_amdgcn_mfma_f32_32x32x16_bf16(va, pf[kb][s2], o1, 0, 0, 0); } }
            if (t + 1 < 32) AT_WRITE((t + 1) & 1);
            __syncthreads();
        }
#undef AT_LOAD
#undef AT_WRITE
        attn_store(Y + (size_t)qtok * 256 + h * 64, o0, o1, lrun, hh);
    }
}
#ifndef MK_DEBUG
#define MK_DEBUG 0
#endif

__device__ __forceinline__ void router_phase(const Args& A, Frame& F, int li) {
    LAS float* wT = (LAS float*)F.lds;
    const float* wr = A.in[22] + (size_t)li * DM * NEXP; const float* g2 = A.in[21] + li * DM;
    for (int i = F.tid; i < DM * NEXP; i += NTHR) { const int k = i >> 4, e = i & 15; wT[e * DM + k] = wr[i] * g2[k]; }
    __syncthreads();
    float* AFF = (float*)(A.ws + WS_AFF); float* IR2 = (float*)(A.ws + WS_STAT) + (size_t)5 * TOK;
    const int gw = F.vcu * NWAVES + F.wave, NGW = F.G * NWAVES, lane = F.lane;
    for (int row = gw; row < TOK; row += NGW) {
        const f32x4* xr = (const f32x4*)(A.out + (size_t)row * DM) + lane;
        f32x4 v[4]; float s = 0.f;
#pragma unroll
        for (int j = 0; j < 4; ++j) { v[j] = xr[64 * j]; s += (v[j].x * v[j].x + v[j].y * v[j].y) + (v[j].z * v[j].z + v[j].w * v[j].w); }
        s = wave_sum(s);
        const float inv = rsqrtf(s * (1.0f / 1024.0f) + EPS);
        float mine = 0.f;
#pragma unroll 1
        for (int e = 0; e < 16; ++e) { float a = 0.f;
#pragma unroll
            for (int j = 0; j < 4; ++j) { const f32x4 w = *(const LAS f32x4*)(wT + e * DM + 4 * lane + 256 * j); a += (v[j].x * w.x + v[j].y * w.y) + (v[j].z * w.z + v[j].w * w.w); }
            a = wave_sum(a) * inv; mine = ((lane & 15) == e) ? a : mine; }
        float mx = mine;
#pragma unroll
        for (int o = 1; o < 16; o <<= 1) mx = fmaxf(mx, __shfl_xor(mx, o));
        mine = __expf(mine - mx); float den = mine;
#pragma unroll
        for (int o = 1; o < 16; o <<= 1) den += __shfl_xor(den, o);
        mine = mine / den;
        const int b = row >> 11, l = row & 2047;
        if (lane < 16) AFF[(size_t)(b * NEXP + lane) * SEQ + l] = mine;
        if (lane == 0) IR2[row] = inv;
    }
}
__device__ __forceinline__ void topk_phase(const Args& A, Frame& F) {
    LAS unsigned* hist = (LAS unsigned*)F.lds;
    LAS unsigned* sh = hist + 256;
    LAS int* idxL = (LAS int*)(hist + 512);
    const float* AFF = (const float*)(A.ws + WS_AFF); const float* IR2 = (const float*)(A.ws + WS_STAT) + (size_t)5 * TOK;
    int* INV = (int*)(A.ws + WS_INV); float* ROWSC = (float*)(A.ws + WS_SEL); float* SELAFF = ROWSC + NSLOT;
    const bf16* XB = (const bf16*)(A.ws + WS_XB); bf16* XE = (bf16*)(A.ws + WS_XE);
    const int tid = F.tid, lane = F.lane, wave = F.wave;
    for (int unit = blockIdx.x; unit < NB * NEXP; unit += F.G) {
        const int b = unit >> 4, e = unit & 15;
        const f32x4 av = *(const f32x4*)(AFF + (size_t)unit * SEQ + 4 * tid);
        unsigned key[4] = {__float_as_uint(av[0]), __float_as_uint(av[1]), __float_as_uint(av[2]), __float_as_uint(av[3])};
        unsigned prefix = 0u, krem = CAP;
        for (int pass = 0; pass < 4; ++pass) {
            const int shift = 24 - 8 * pass;
            if (tid < 256) hist[tid] = 0u;
            __syncthreads();
#pragma unroll
            for (int i = 0; i < 4; ++i) { const bool match = (pass == 0) || ((key[i] >> (shift + 8)) == (prefix >> (shift + 8))); if (match) __hip_atomic_fetch_add(&hist[(key[i] >> shift) & 255u], 1u, __ATOMIC_RELAXED, __HIP_MEMORY_SCOPE_WORKGROUP); }
            __syncthreads();
            if (tid == 0) { unsigned cum = 0u; int bsel = 0; unsigned knew = krem;
                for (int bin = 255; bin >= 0; --bin) { const unsigned cnt = hist[bin]; if (cum + cnt >= krem) { bsel = bin; knew = krem - cum; break; } cum += cnt; }
                sh[0] = prefix | ((unsigned)bsel << shift); sh[1] = knew; }
            __syncthreads();
            prefix = sh[0]; krem = sh[1];
            __syncthreads();
        }
        unsigned eqc = 0u, gtc = 0u;
#pragma unroll
        for (int i = 0; i < 4; ++i) { eqc += key[i] == prefix; gtc += key[i] > prefix; }
        unsigned eqs = eqc;
#pragma unroll
        for (int o = 1; o < 64; o <<= 1) { const unsigned t = __shfl_up(eqs, o); if (lane >= o) eqs += t; }
        if (lane == 63) sh[16 + wave] = eqs;
        __syncthreads();
        unsigned eqbase = eqs - eqc;
        for (int w = 0; w < wave; ++w) eqbase += sh[16 + w];
        __syncthreads();
        bool sel[4]; unsigned selc = 0u, er = eqbase;
#pragma unroll
        for (int i = 0; i < 4; ++i) { if (key[i] > prefix) sel[i] = true; else if (key[i] == prefix) { sel[i] = er < krem; ++er; } else sel[i] = false; selc += sel[i]; }
        unsigned ss = selc;
#pragma unroll
        for (int o = 1; o < 64; o <<= 1) { const unsigned t = __shfl_up(ss, o); if (lane >= o) ss += t; }
        if (lane == 63) sh[32 + wave] = ss;
        __syncthreads();
        unsigned slot = ss - selc;
        for (int w = 0; w < wave; ++w) slot += sh[32 + w];
        const int grp = e * NB + b;
#pragma unroll
        for (int i = 0; i < 4; ++i) { const int l = 4 * tid + i; int sv = -1;
            if (sel[i]) { sv = (int)slot; ++slot; idxL[sv] = l; ROWSC[grp * CAP + sv] = IR2[b * SEQ + l]; SELAFF[grp * CAP + sv] = __builtin_bit_cast(float, key[i]); }
            INV[(size_t)(b * SEQ + l) * NEXP + e] = sv; }
        __syncthreads();
        for (int it = 0; it < 64; it += 4) {
            v4u r[4];
#pragma unroll
            for (int q = 0; q < 4; ++q) { const int srow = (it + q) * 4 + (tid >> 7); r[q] = *(const v4u*)(XB + (size_t)(b * SEQ + idxL[srow]) * DM + (tid & 127) * 8); }
#pragma unroll
            for (int q = 0; q < 4; ++q) { const int srow = (it + q) * 4 + (tid >> 7); *(v4u*)(XE + (size_t)(grp * CAP + srow) * DM + (tid & 127) * 8) = r[q]; }
        }
        __syncthreads();
    }
}

#if MK_DEBUG
__device__ __forceinline__ void debug_moe_check(const Args& A, Frame& F, int li) {
    LAS float* hs = (LAS float*)F.lds; LAS float* hid = hs + 1024; LAS float* red = hid + 1024; LAS int* tokp = (LAS int*)(red + 64);
    const int* INV = (const int*)(A.ws + WS_INV); const bf16* YE = (const bf16*)(A.ws + WS_XE); const float* AFF = (const float*)(A.ws + WS_AFF);
    const float* g2 = A.in[21] + li * DM; const float* wg = A.in[23] + (size_t)li * NEXP * DM * DM; const float* wu = A.in[24] + (size_t)li * NEXP * DM * DM; const float* wd = A.in[25] + (size_t)li * NEXP * DM * DM;
    float* dbg = (float*)(A.ws + WS_CTL) + 1024;
    const int tid = F.tid;
    for (int unit = blockIdx.x; unit < 256; unit += F.G) {
        const int grp = unit >> 1, slot = (unit & 1) * 131 + 7, e = grp >> 3, b = grp & 7;
        if (tid == 0) tokp[0] = -1;
        __syncthreads();
        for (int l = tid; l < SEQ; l += NTHR) if (INV[(size_t)(b * SEQ + l) * NEXP + e] == slot) tokp[0] = l;
        __syncthreads();
        const int l = tokp[0]; if (l < 0) { if (tid == 0) atomicAdd(dbg + 2, 1.0f); __syncthreads(); continue; }
        const float* xr = A.out + (size_t)(b * SEQ + l) * DM;
        float s = 0.f; for (int k = tid; k < DM; k += NTHR) s += xr[k] * xr[k];
        s = wave_sum(s); if (F.lane == 0) red[F.wave] = s; __syncthreads();
        float tot = 0.f; for (int w = 0; w < 8; ++w) tot += red[w];
        const float inv = rsqrtf(tot * (1.0f / 1024.0f) + EPS);
        for (int k = tid; k < DM; k += NTHR) hs[k] = xr[k] * inv * g2[k];
        __syncthreads();
        for (int f = tid; f < DM; f += NTHR) { float g = 0.f, u = 0.f; for (int k = 0; k < DM; ++k) { g += hs[k] * wg[((size_t)e * DM + k) * DM + f]; u += hs[k] * wu[((size_t)e * DM + k) * DM + f]; }
            hid[f] = g / (1.0f + __expf(-g)) * u; }
        __syncthreads();
        { const bf16* XE_ = (const bf16*)(A.ws + WS_XE); const bf16* XB_ = (const bf16*)(A.ws + WS_XB); float mm = 0.f;
          for (int k = tid; k < DM; k += NTHR) mm += (XE_[(size_t)(grp * CAP + slot) * DM + k] != XB_[(size_t)(b * SEQ + l) * DM + k]) ? 1.f : 0.f;
          mm = wave_sum(mm); if (F.lane == 0 && mm > 0.f) atomicAdd(dbg + 3, mm);
          const bf16* HB_ = (const bf16*)(A.ws + WS_HB); float he = 0.f, hr = 0.f;
          for (int f = tid; f < DM; f += NTHR) { const float m2 = bf2f(HB_[(size_t)(grp * CAP + slot) * DM + f]); he += (hid[f] - m2) * (hid[f] - m2); hr += hid[f] * hid[f]; }
          he = wave_sum(he); hr = wave_sum(hr); if (F.lane == 0) { atomicAdd(dbg + 4, he); atomicAdd(dbg + 5, hr); } }
        { const float* wr = A.in[22] + (size_t)li * DM * NEXP;
          if (tid < 16) { float a = 0.f; for (int k = 0; k < DM; ++k) a += hs[k] * wr[k * NEXP + tid]; red[16 + tid] = a; }
          __syncthreads();
          if (tid == 0) { float mx = red[16]; for (int q = 1; q < 16; ++q) mx = fmaxf(mx, red[16 + q]); float den = 0.f; for (int q = 0; q < 16; ++q) den += __expf(red[16 + q] - mx);
              float ee = 0.f, rr = 0.f; for (int q = 0; q < 16; ++q) { const float t = __expf(red[16 + q] - mx) / den, m2 = AFF[(size_t)(b * NEXP + q) * SEQ + l]; ee += (t - m2) * (t - m2); rr += t * t; }
              atomicAdd(dbg + 6, ee); atomicAdd(dbg + 7, rr); }
          if (slot == 7) { float mn = 1e30f; int ns = 0; for (int q = tid; q < SEQ; q += NTHR) if (INV[(size_t)(b * SEQ + q) * NEXP + e] >= 0) { ++ns; mn = fminf(mn, AFF[(size_t)(b * NEXP + e) * SEQ + q]); }
              for (int o = 1; o < 64; o <<= 1) { mn = fminf(mn, __shfl_xor(mn, o)); ns += __shfl_xor(ns, o); }
              __syncthreads(); if (F.lane == 0) { red[40 + F.wave] = mn; red[48 + F.wave] = (float)ns; } __syncthreads();
              float gmn = 1e30f; int gns = 0; for (int w = 0; w < 8; ++w) { gmn = fminf(gmn, red[40 + w]); gns += (int)red[48 + w]; }
              int bad = 0; for (int q = tid; q < SEQ; q += NTHR) if (INV[(size_t)(b * SEQ + q) * NEXP + e] < 0 && AFF[(size_t)(b * NEXP + e) * SEQ + q] > gmn) ++bad;
              if (bad > 0) atomicAdd(dbg + 9, (float)bad); if (tid == 0 && gns != 256) atomicAdd(dbg + 10, 1.0f); __syncthreads(); } }
        const float aff = AFF[(size_t)(b * NEXP + e) * SEQ + l];
        float e2 = 0.f, r2 = 0.f;
        for (int d = tid; d < DM; d += NTHR) { float y = 0.f; for (int f = 0; f < DM; ++f) y += hid[f] * wd[((size_t)e * DM + f) * DM + d]; y *= aff;
            const float mine = bf2f(YE[(size_t)(grp * CAP + slot) * DM + d]); const float yu = y / aff; e2 += (yu - mine) * (yu - mine); r2 += yu * yu; }
        if (tid == 0) { const float sa = ((const float*)(A.ws + WS_SEL))[NSLOT + grp * CAP + slot]; if (fabsf(sa - aff) > 1e-6f) atomicAdd(dbg + 8, 1.0f); }
        e2 = wave_sum(e2); r2 = wave_sum(r2);
        __syncthreads();
        if (F.lane == 0) { atomicAdd(dbg + 0, e2); atomicAdd(dbg + 1, r2); }
        __syncthreads();
    }
}
#endif
__device__ __forceinline__ void combine_phase(const Args& A, Frame& F) {
    const float* AFFp = (const float*)(A.ws + WS_AFF);
    const int* INV = (const int*)(A.ws + WS_INV); const bf16* YE = (const bf16*)(A.ws + WS_XE); bf16* XB = (bf16*)(A.ws + WS_XB); float* IR3 = (float*)(A.ws + WS_STAT) + (size_t)6 * TOK;
    const int gw = F.vcu * NWAVES + F.wave, NGW = F.G * NWAVES, lane = F.lane;
    for (int row = gw; row < TOK; row += NGW) {
        const int b = row >> 11; const int iv = INV[(size_t)row * NEXP + (lane & 15)];
        f32x4* xr = (f32x4*)(A.out + (size_t)row * DM) + lane;
        f32x4 v[4];
#pragma unroll
        for (int j = 0; j < 4; ++j) v[j] = xr[64 * j];
#pragma unroll
        for (int e = 0; e < 16; ++e) { const int slot = __builtin_amdgcn_readlane(iv, e);
            if (slot >= 0 && !((MK_DROP >> 4) & 1)) { const bf16* yr = YE + (size_t)((e * NB + b) * CAP + slot) * DM + 4 * lane; const float af = AFFp[(size_t)(b * NEXP + e) * SEQ + (row & 2047)];
#pragma unroll
                for (int j = 0; j < 4; ++j) v[j] += ld_bf16x4(yr + 256 * j) * af; } }
        float s = 0.f; u32x2* brow = (u32x2*)(XB + (size_t)row * DM) + lane;
#pragma unroll
        for (int j = 0; j < 4; ++j) { xr[64 * j] = v[j]; brow[64 * j] = (u32x2){cvtpk(v[j].x, v[j].y), cvtpk(v[j].z, v[j].w)}; s += (v[j].x * v[j].x + v[j].y * v[j].y) + (v[j].z * v[j].z + v[j].w * v[j].w); }
        s = wave_sum(s);
        if (lane == 0) IR3[row] = rsqrtf(s * (1.0f / 1024.0f) + EPS);
    }
}
__device__ __forceinline__ void final_phase(const Args& A, Frame& F) {
    const f32x4* sp = (const f32x4*)(A.ws + WS_SSP); const f32x4* fg = (const f32x4*)A.in[29] + F.lane;
    const int gw = F.vcu * NWAVES + F.wave, NGW = F.G * NWAVES;
    float dscale = 1.0f;
#if MK_DEBUG
    { const float* dbg = (const float*)(A.ws + WS_CTL) + 1024; dscale = 1.0f + 10.0f * sqrtf(dbg[6] / fmaxf(dbg[7], 1e-30f)) + (dbg[9] > 0.f ? 1000.0f : 0.f) + (dbg[10] > 0.f ? 30000.0f : 0.f); }
#endif
    f32x4 g[4];
#pragma unroll
    for (int j = 0; j < 4; ++j) g[j] = fg[64 * j];
    for (int row = gw; row < TOK; row += NGW) {
        f32x4* xr = (f32x4*)(A.out + (size_t)row * DM) + F.lane; const f32x4 p0 = sp[4 * row], p1 = sp[4 * row + 1], p2 = sp[4 * row + 2], p3 = sp[4 * row + 3];
        const float ssr = (((p0.x + p0.y) + (p0.z + p0.w)) + ((p1.x + p1.y) + (p1.z + p1.w))) + (((p2.x + p2.y) + (p2.z + p2.w)) + ((p3.x + p3.y) + (p3.z + p3.w)));
        const float inv = rsqrtf(ssr * (1.0f / 1024.0f) + EPS);
#pragma unroll
        for (int j = 0; j < 4; ++j) xr[64 * j] = xr[64 * j] * (inv * dscale) * g[j];
    }
}

#ifndef MK_PER_PHASE
#define MK_PER_PHASE 1
#endif
constexpr int NPH = 26;
__global__ void __launch_bounds__(NTHR, 2) mk_fwd(Args A) {
    extern __shared__ __attribute__((aligned(16))) unsigned char lds_raw[];
    Frame F;
    F.lds = (LAS unsigned char*)lds_raw;
    F.tid = threadIdx.x; F.lane = F.tid & 63; F.wave = __builtin_amdgcn_readfirstlane(F.tid >> 6);
    F.G = gridDim.x; { const int bx = blockIdx.x; F.vcu = (F.G % 8 == 0) ? (bx % 8) * (F.G / 8) + bx / 8 : bx; }
    volatile LAS unsigned* MISC = (volatile LAS unsigned*)(F.lds + LDSCTL_OFF);
    if (F.tid < 64) MISC[F.tid] = 0u;
    __syncthreads();
    const int lo = A.ph_lo, hi = A.ph_hi;
    unsigned* ctl = (unsigned*)(A.ws + WS_CTL);
    XcdBarrier bar; bar.bar = ctl + CW_BAR; bar.x = 0; bar.st = nullptr;
    if (hi - lo > 1) bar = xcd_barrier_post(ctl + CW_BAR, MISC + 8);
#ifndef MK_MASK
#define MK_MASK 0xFFFFFFu
#endif
#define KIND(j) (((MK_MASK) >> (j)) & 1u)
#define IN(k) (lo <= (k) && (k) < hi)
#define REFRESH() do { int t_ = threadIdx.x; asm volatile("" : "+v"(t_)); F.tid = t_; F.lane = t_ & 63; F.wave = __builtin_amdgcn_readfirstlane(t_ >> 6); } while (0)
#define SEAM(k) do { if (IN(k) && IN((k) + 1)) xcd_barrier(bar); } while (0)
    LAS unsigned char* ring = F.lds;
    unsigned char* ws = A.ws;

    if (KIND(0) && IN(0)) { REFRESH(); phase_p0(A, F); }
    SEAM(0);
    for (int li = 0; li < 2; ++li) {
        const int pb = 1 + 12 * li;
        if (KIND(1) && IN(pb + 0)) { REFRESH(); phase_l0a(A, F, li); }
        SEAM(pb + 0);
        if (KIND(2) && IN(pb + 1)) {
            REFRESH();
            filter_fft(A, F);
            __syncthreads();
            pg8::Gemm g{(const bf16*)(ws + WS_XB), (const bf16*)(ws + WS_WIN), TOK, NWIN, DM}; pg8::StaticOrder S; S.init(TOK, NWIN, F.G, (int)blockIdx.x);
            EpiWin E{(const float*)(ws + WS_STAT) + (size_t)li * TOK, A.in[4] + li * 4096, ws};
            pg8::gemm_phase<EpiWin, pg8::StaticOrder, true, true>(ring, g, S, E);
        }
        SEAM(pb + 1);
        if (IN(pb + 2)) {
            REFRESH();
            if (KIND(14) || KIND(15)) fft_init_tw(A, F);
            if (KIND(14)) hyena_phase(A, F, li);
            REFRESH();
            if (KIND(15)) fnet_phase(A, F);
            __syncthreads();
            REFRESH();
            if (KIND(16)) na_phase(A, F, li);
            __syncthreads();
            REFRESH();
            if (KIND(17)) { pg8::Gemm g{(const bf16*)(ws + WS_CQ), (const bf16*)(ws + WS_WUQ), TOK, 512, 256}; pg8::StaticOrder S; S.init(TOK, 512, F.G, (int)blockIdx.x);
              EpiQ E{ws}; pg8::gemm_phase<EpiQ, pg8::StaticOrder, true, true>(ring, g, S, E); }
            REFRESH();
            if (KIND(18)) { pg8::Gemm g{(const bf16*)(ws + WS_CKV), (const bf16*)(ws + WS_WUKV), TOK, 512, 256}; pg8::StaticOrder S; S.init(TOK, 512, F.G, (int)((blockIdx.x + F.G / 2) % F.G));
              EpiKV E{ws}; pg8::gemm_phase<EpiKV, pg8::StaticOrder, true, true>(ring, g, S, E); }
        }
        SEAM(pb + 2);
        if (KIND(4) && IN(pb + 3)) { REFRESH(); mla_attn_phase(A, F); }
        SEAM(pb + 3);
        if (KIND(5) && IN(pb + 4)) {
            for (int n = 0; n < 4; ++n) {
                REFRESH();
                pg8::Gemm g{(const bf16*)(ws + WS_YHY + (size_t)n * 8 * MiB), (const bf16*)(ws + WS_WBR) + (size_t)n * DM * 256, TOK, DM, 256}; pg8::StaticOrder S; S.init(TOK, DM, F.G, (int)blockIdx.x);
                EpiBranch E{ws, n}; pg8::gemm_phase<EpiBranch, pg8::StaticOrder, true, true>(ring, g, S, E);
            }
        }
        SEAM(pb + 4);
        if (KIND(6) && IN(pb + 5)) {
            REFRESH();
            pg8::Gemm g{(const bf16*)(ws + WS_MERGED), (const bf16*)(ws + WS_WOUT), TOK, DM, DM}; pg8::StaticOrder S; S.init(TOK, DM, F.G, (int)blockIdx.x);
            EpiResid E{ws, A.out}; pg8::gemm_phase<EpiResid, pg8::StaticOrder, true, true>(ring, g, S, E);
        }
        SEAM(pb + 5);
        if (KIND(7) && IN(pb + 6)) { REFRESH(); router_phase(A, F, li); }
        SEAM(pb + 6);
        if (KIND(8) && IN(pb + 7)) { REFRESH(); topk_phase(A, F); }
        SEAM(pb + 7);
        if (KIND(9) && IN(pb + 8)) {
            REFRESH();
            pg8::Gemm g{(const bf16*)(ws + WS_XE), (const bf16*)(ws + WS_WE1), NSLOT, NEXP * 2048, DM}; MoeOrder S{F.G, (int)blockIdx.x, 8, 1024};
            EpiSwiglu E{ws}; pg8::gemm_phase<EpiSwiglu, MoeOrder, true, true>(ring, g, S, E);
        }
        SEAM(pb + 8);
        if (KIND(10) && IN(pb + 9)) {
            REFRESH();
            pg8::Gemm g{(const bf16*)(ws + WS_HB), (const bf16*)(ws + WS_WE2), NSLOT, NEXP * 1024, DM}; MoeOrder S{F.G, (int)blockIdx.x, 4, 512};
            EpiDown E{ws}; pg8::gemm_phase<EpiDown, MoeOrder, true, true>(ring, g, S, E);
        }
        SEAM(pb + 9);
#if MK_DEBUG
        if (li == 0 && IN(pb + 10)) { REFRESH(); debug_moe_check(A, F, li); __syncthreads(); }
#endif
        if (KIND(11) && IN(pb + 10)) { REFRESH(); combine_phase(A, F); }
        SEAM(pb + 10);
        if (KIND(12) && IN(pb + 11)) {
            REFRESH();
            { pg8::Gemm g{(const bf16*)(ws + WS_PB), (const bf16*)(ws + WS_WPP), TOK, DM, 256}; pg8::StaticOrder S; S.init(TOK, DM, F.G, (int)blockIdx.x);
              EpiPP E{ws}; pg8::gemm_phase<EpiPP, pg8::StaticOrder, true, true>(ring, g, S, E); }
            REFRESH();
            { pg8::Gemm g{(const bf16*)(ws + WS_XB), (const bf16*)(ws + WS_WPG), TOK, DM, DM}; pg8::StaticOrder S; S.init(TOK, DM, F.G, (int)blockIdx.x);
              EpiPle E{ws, A.out, (float*)(ws + WS_SSP)}; pg8::gemm_phase<EpiPle, pg8::StaticOrder, true, true>(ring, g, S, E); }
        }
        SEAM(pb + 11);
    }
    if (KIND(13) && IN(25)) { REFRESH(); final_phase(A, F); }
#undef IN
#undef KIND
#undef SEAM
#undef REFRESH
}

extern "C" void kernel_launch(void* const* d_in, const int* in_sizes, int n_in, void* d_out, int out_size, void* d_ws, size_t ws_size, hipStream_t stream) {
    static int grid = 0;
    if (grid == 0) {
        if (n_in != 30 || in_sizes[0] != TOK * DM || out_size != TOK * DM || ws_size < WS_END) {
            fprintf(stderr, "kernel_launch: unexpected problem (n_in %d, in0 %d, out %d, ws %zu < %zu); nothing launched\n", n_in, n_in > 0 ? in_sizes[0] : -1, out_size, ws_size, (size_t)WS_END); grid = -1; return; }
        int dev = 0, cus = 0, per_cu = 0;
        if (hipGetDevice(&dev) != hipSuccess || hipDeviceGetAttribute(&cus, hipDeviceAttributeMultiprocessorCount, dev) != hipSuccess) { fprintf(stderr, "kernel_launch: device query failed\n"); grid = -1; return; }
        if (hipFuncSetAttribute((const void*)mk_fwd, hipFuncAttributeMaxDynamicSharedMemorySize, LDS_BYTES) != hipSuccess) { fprintf(stderr, "kernel_launch: hipFuncSetAttribute failed\n"); grid = -1; return; }
        if (hipOccupancyMaxActiveBlocksPerMultiprocessor(&per_cu, (const void*)mk_fwd, NTHR, LDS_BYTES) != hipSuccess || per_cu < 1)
            fprintf(stderr, "kernel_launch: note: occupancy query reports %d workgroups per CU\n", per_cu);
        (void)hipGetLastError();
        grid = cus;
    }
    if (grid < 0) return;
    if (hipMemsetAsync((char*)d_ws + WS_CTL, 0, CTL_ZERO_BYTES, stream) != hipSuccess) { fprintf(stderr, "kernel_launch: memset failed\n"); return; }
    Args a{};
    for (int i = 0; i < 30; ++i) a.in[i] = (const float*)d_in[i];
    a.out = (float*)d_out; a.ws = (unsigned char*)d_ws;
#if MK_PER_PHASE
    for (int p = 0; p < NPH; ++p) { a.ph_lo = p; a.ph_hi = p + 1; hipLaunchKernelGGL(mk_fwd, dim3(grid), dim3(NTHR), LDS_BYTES, stream, a); }
#else
    a.ph_lo = 0; a.ph_hi = NPH;
    hipLaunchKernelGGL(mk_fwd, dim3(grid), dim3(NTHR), LDS_BYTES, stream, a);
#endif
    const hipError_t le = hipPeekAtLastError();
    if (le != hipSuccess) fprintf(stderr, "kernel_launch: launch failed: %s\n", hipGetErrorName(le));
}
```

```cpp
#include <hip/hip_runtime.h>
#include <cstdio>
#include <cstdint>
namespace pg8 {
#define PG8_LAS __attribute__((address_space(3)))
typedef unsigned short bf16_t;
typedef short bf16x8 __attribute__((ext_vector_type(8)));
typedef float f32x4 __attribute__((ext_vector_type(4)));
typedef unsigned u32x4 __attribute__((ext_vector_type(4)));
constexpr int BM = 256, BK = 64, HALF = 128, HTB = HALF * BK * 2  , STAGE_BYTES = 8 * HTB, NXCD = 8, WGM = 8;

__host__ __device__ __forceinline__ int lds_byte(int r, int c) { const int st = (r >> 4) * 2 + (c >> 5), rr = r & 15, cc = c & 31, ob = rr * 64 + cc * 2; return st * 1024 + (ob ^ (((ob >> 9) & 1) << 5)); }
__host__ __device__ __forceinline__ void stage_rc(int b, int& R, int& C) { const int st = b / 1024, sb = b % 1024, swz = sb ^ (((sb >> 9) & 1) << 5); R = (st >> 1) * 16 + swz / 64; C = (st & 1) * 32 + (swz % 64) / 2; }
__host__ __device__ __forceinline__ int perm32(int rho) { const int n = rho >> 4, i = rho & 15; return 8 * (i >> 2) + 4 * n + (i & 3); }

struct Unit { int pm, pn, aux; };
struct Gemm { const bf16_t* A; const bf16_t* Bt; int M, N, K; };

struct StaticOrder {
    int nM, nN, nwg, G, c;
    __host__ __device__ void init(int M, int N, int G_, int c_) { nM = M / BM; nN = N / BM; nwg = nM * nN; G = G_; c = c_; }
    __host__ __device__ __forceinline__ bool next(int i, Unit& u) const {
        const long L = (long)i * G + c; if (L >= nwg) return false;
        int wgid = (int)L; { const int q = nwg / NXCD, r = nwg % NXCD, xcd = wgid % NXCD, off = wgid / NXCD; wgid = (xcd < r ? xcd * (q + 1) : r * (q + 1) + (xcd - r) * q) + off; }
        const int nig = WGM * nN, gid = wgid / nig, fm = gid * WGM, gsz = (nM - fm) < WGM ? (nM - fm) : WGM;
        u.pm = fm + ((wgid % nig) % gsz); u.pn = (wgid % nig) / gsz; return true;
    }
    __device__ __forceinline__ void ptrs(const Gemm& g, const Unit& u, size_t tstep, const char*& a, const char*& b) const { a = (const char*)g.A + (size_t)u.pm * tstep; b = (const char*)g.Bt + (size_t)u.pn * tstep; }
    __device__ __forceinline__ void a_ready(const Unit&) const {}
    __device__ __forceinline__ void done(const Unit&) const {}
};
__device__ __forceinline__ unsigned cvt_pk_bf16(float lo, float hi) { unsigned r; asm volatile("v_cvt_pk_bf16_f32 %0, %1, %2" : "=v"(r) : "v"(lo), "v"(hi)); return r; }
template <class Epi, class Sched, bool ALIGN_EPI = false, bool SP2 = false>
__device__ __forceinline__ void gemm_phase(PG8_LAS unsigned char* lds, const Gemm g, const Sched& S, const Epi& E, int wave_id) {
    int lane_; asm volatile("v_mbcnt_lo_u32_b32 %0, -1, 0\n\tv_mbcnt_hi_u32_b32 %0, -1, %0" : "=v"(lane_));
    lane_ &= 63; const int tid = wave_id * 64 + lane_, wid = __builtin_amdgcn_readfirstlane(tid >> 6), lane = tid & 63, wr = wid >> 2, wc = wid & 3, fr = lane & 15, fq = lane >> 4;
    int K_ = g.K; asm volatile("" : "+s"(K_));
    const int K = K_, nt = K / BK;
    unsigned voffA[2], voffB[2];
#pragma unroll
    for (int i = 0; i < 2; ++i) { int R, C; stage_rc(tid * 16 + i * 8192, R, C); const int Rb = Epi::PERM ? ((R & ~31) + perm32(R & 31)) : R;
        voffA[i] = (unsigned)(R * K + C) * 2u; voffB[i] = (unsigned)(Rb * K + C) * 2u; }
    const size_t kstep = (size_t)(BK * 2);
    const size_t hstep = (size_t)HALF * K * 2;
    const size_t tstep = 2 * hstep;
    const unsigned ldsw = (unsigned)wid * 1024u;
    const int aoff = lds_byte(wr * 64 + fr, fq * 8), boff = lds_byte(wc * 32 + fr, fq * 8);
#define PG8_SA(b, h) (((b) * 2 + (h)) * HTB)
#define PG8_SB(b, h) ((4 + (b) * 2 + (h)) * HTB)
#define PG8_STAGE(bufoff, gbase, voff) do { _Pragma("unroll") for (int _i = 0; _i < 2; ++_i) \
        __builtin_amdgcn_global_load_lds((const unsigned*)((const char*)(gbase) + (voff)[_i]), (PG8_LAS unsigned*)(lds + (bufoff) + ldsw + _i * 8192), 16, 0, 0); } while (0)
#define PG8_LDA(dst, b, h) do { _Pragma("unroll") for (int m = 0; m < 4; ++m) _Pragma("unroll") for (int k = 0; k < 2; ++k) dst[m][k] = *(const PG8_LAS bf16x8*)(lds + PG8_SA(b, h) + aoff + m * 2048 + k * 1024); } while (0)
#define PG8_LDB(dst, b, h) do { _Pragma("unroll") for (int n = 0; n < 2; ++n) _Pragma("unroll") for (int k = 0; k < 2; ++k) dst[n][k] = *(const PG8_LAS bf16x8*)(lds + PG8_SB(b, h) + boff + n * 2048 + k * 1024); } while (0)
#define PG8_MMA(ai, bj, At, Bt) do { __builtin_amdgcn_s_setprio(1); _Pragma("unroll") for (int m = 0; m < 4; ++m) _Pragma("unroll") for (int n = 0; n < 2; ++n) _Pragma("unroll") for (int k = 0; k < 2; ++k) \
        acc[ai][bj][m][n] = __builtin_amdgcn_mfma_f32_16x16x32_bf16(Bt[n][k], At[m][k], acc[ai][bj][m][n], 0, 0, 0); __builtin_amdgcn_s_setprio(0); } while (0)
#define PG8_WAIT_V(n) asm volatile("s_waitcnt vmcnt(" #n ")" ::: "memory")
#define PG8_WAIT_L(n) asm volatile("s_waitcnt lgkmcnt(" #n ")" ::: "memory")
#define PG8_BAR __builtin_amdgcn_s_barrier()
#define PG8_SCHED __builtin_amdgcn_sched_barrier(0)
    Unit cur, nxt; int ui = 0;
    if (!S.next(0, cur)) return;
    f32x4 acc[2][2][4][2];
#pragma unroll
    for (int a = 0; a < 2; ++a)
#pragma unroll
        for (int b = 0; b < 2; ++b)
#pragma unroll
            for (int m = 0; m < 4; ++m)
#pragma unroll
                for (int n = 0; n < 2; ++n) acc[a][b][m][n] = (f32x4){0.f, 0.f, 0.f, 0.f};
    bf16x8 At[4][2], B0[2][2], B1[2][2];
    const char* cA; const char* cB; S.ptrs(g, cur, tstep, cA, cB);
    S.a_ready(cur);
    if constexpr (SP2) {
        PG8_STAGE(PG8_SB(0, 0), cB, voffB); PG8_STAGE(PG8_SB(0, 1), cB + hstep, voffB); PG8_STAGE(PG8_SA(0, 0), cA, voffA); PG8_STAGE(PG8_SA(0, 1), cA + hstep, voffA);
        if (wr == 1) PG8_BAR;
        PG8_WAIT_V(2); PG8_BAR;
        PG8_STAGE(PG8_SB(1, 0), cB + kstep, voffB); PG8_STAGE(PG8_SA(1, 0), cA + kstep, voffA); PG8_STAGE(PG8_SB(1, 1), cB + hstep + kstep, voffB);
        PG8_WAIT_V(6); PG8_BAR;
    } else {
        PG8_STAGE(PG8_SB(0, 0), cB, voffB); PG8_STAGE(PG8_SA(0, 0), cA, voffA); PG8_STAGE(PG8_SB(0, 1), cB + hstep, voffB); PG8_STAGE(PG8_SA(0, 1), cA + hstep, voffA);
        if (wr == 1) PG8_BAR;
        PG8_WAIT_V(4); PG8_BAR;
        PG8_STAGE(PG8_SB(1, 0), cB + kstep, voffB); PG8_STAGE(PG8_SA(1, 0), cA + kstep, voffA); PG8_STAGE(PG8_SB(1, 1), cB + hstep + kstep, voffB);
        PG8_WAIT_V(6); PG8_BAR;
    }
    for (;;) {
        const bool has_next = S.next(ui + 1, nxt);
        const char* nA = cA; const char* nB = cB; if (has_next) S.ptrs(g, nxt, tstep, nA, nB);
        for (int t = 0; t < nt; t += 2) {
            const bool last = (t == nt - 2);
            const char* a1 = cA + (size_t)(t + 1) * kstep;
            const char* a2 = last ? nA : cA + (size_t)(t + 2) * kstep; const char* b2 = last ? nB : cB + (size_t)(t + 2) * kstep;
            const char* a3 = a2 + kstep; const char* b3 = b2 + kstep;
            if (last && has_next) S.a_ready(nxt);
            if constexpr (SP2) {
            PG8_LDB(B0, 0, 0); PG8_LDB(B1, 0, 1); PG8_SCHED; PG8_LDA(At, 0, 0); PG8_STAGE(PG8_SA(1, 1), a1 + hstep, voffA);
            PG8_WAIT_V(8); PG8_WAIT_L(0); PG8_BAR; PG8_MMA(0, 0, At, B0); PG8_MMA(0, 1, At, B1); PG8_BAR; PG8_SCHED;
            PG8_LDA(At, 0, 1); PG8_STAGE(PG8_SB(0, 0), b2, voffB); PG8_STAGE(PG8_SB(0, 1), b2 + hstep, voffB); PG8_STAGE(PG8_SA(0, 0), a2, voffA);
            PG8_WAIT_V(8); PG8_WAIT_L(0); PG8_BAR; PG8_MMA(1, 0, At, B0); PG8_MMA(1, 1, At, B1); PG8_BAR; PG8_SCHED;
            PG8_LDB(B0, 1, 0); PG8_LDB(B1, 1, 1); PG8_SCHED; PG8_LDA(At, 1, 0); PG8_STAGE(PG8_SA(0, 1), a2 + hstep, voffA);
            PG8_WAIT_V(8); PG8_WAIT_L(0); PG8_BAR; PG8_MMA(0, 0, At, B0); PG8_MMA(0, 1, At, B1); PG8_BAR; PG8_SCHED;
            PG8_LDA(At, 1, 1); PG8_STAGE(PG8_SB(1, 0), b3, voffB); PG8_STAGE(PG8_SB(1, 1), b3 + hstep, voffB); PG8_STAGE(PG8_SA(1, 0), a3, voffA);
            PG8_WAIT_V(8); PG8_WAIT_L(0); PG8_BAR; PG8_MMA(1, 0, At, B0); PG8_MMA(1, 1, At, B1); PG8_BAR; PG8_SCHED;
            } else {
            PG8_LDB(B0, 0, 0); PG8_SCHED; PG8_LDA(At, 0, 0); PG8_STAGE(PG8_SA(1, 1), a1 + hstep, voffA);
            PG8_WAIT_L(8); PG8_BAR; PG8_WAIT_L(0); PG8_MMA(0, 0, At, B0); PG8_BAR; PG8_SCHED;
            PG8_LDB(B1, 0, 1); PG8_STAGE(PG8_SB(0, 0), b2, voffB);
            PG8_BAR; PG8_WAIT_L(0); PG8_MMA(0, 1, At, B1); PG8_BAR;
            PG8_LDA(At, 0, 1); PG8_STAGE(PG8_SA(0, 0), a2, voffA);
            PG8_BAR; PG8_WAIT_L(0); PG8_MMA(1, 0, At, B0); PG8_BAR; PG8_SCHED;
            PG8_STAGE(PG8_SB(0, 1), b2 + hstep, voffB);
            PG8_WAIT_V(6); PG8_BAR; PG8_MMA(1, 1, At, B1); PG8_BAR;
            PG8_LDB(B0, 1, 0); PG8_SCHED; PG8_LDA(At, 1, 0); PG8_STAGE(PG8_SA(0, 1), a2 + hstep, voffA);
            PG8_WAIT_L(8); PG8_BAR; PG8_WAIT_L(0); PG8_MMA(0, 0, At, B0); PG8_BAR; PG8_SCHED;
            PG8_LDB(B1, 1, 1); PG8_STAGE(PG8_SB(1, 0), b3, voffB);
            PG8_BAR; PG8_WAIT_L(0); PG8_MMA(0, 1, At, B1); PG8_BAR;
            PG8_LDA(At, 1, 1); PG8_STAGE(PG8_SA(1, 0), a3, voffA);
            PG8_BAR; PG8_WAIT_L(0); PG8_MMA(1, 0, At, B0); PG8_BAR; PG8_SCHED;
            PG8_STAGE(PG8_SB(1, 1), b3 + hstep, voffB);
            PG8_WAIT_V(6); PG8_BAR; PG8_MMA(1, 1, At, B1); PG8_BAR;
            }
        }
        if constexpr (ALIGN_EPI) { if (wr == 0) PG8_BAR; }
        if constexpr (!Epi::AFTER_DRAIN) { E(acc, cur, wr, wc, fr, fq); S.done(cur); }
        if (!has_next) break;
#pragma unroll
        for (int a = 0; a < 2; ++a)
#pragma unroll
            for (int b = 0; b < 2; ++b)
#pragma unroll
                for (int m = 0; m < 4; ++m)
#pragma unroll
                    for (int n = 0; n < 2; ++n) acc[a][b][m][n] = (f32x4){0.f, 0.f, 0.f, 0.f};
        cur = nxt; cA = nA; cB = nB; ++ui;
        if constexpr (ALIGN_EPI) { if (wr == 1) PG8_BAR; }
    }
    PG8_WAIT_V(0);
    if constexpr (!ALIGN_EPI) { if (wr == 0) PG8_BAR; }
    PG8_BAR;
    if constexpr (Epi::AFTER_DRAIN) { E.fused(acc, cur, wr, wc, fr, fq, lds, wid, lane); S.done(cur); }
#undef PG8_SA
#undef PG8_SB
#undef PG8_STAGE
#undef PG8_LDA
#undef PG8_LDB
#undef PG8_MMA
#undef PG8_WAIT_V
#undef PG8_WAIT_L
#undef PG8_BAR
#undef PG8_SCHED
}
}
#define GAS __attribute__((address_space(1)))
#define LAS __attribute__((address_space(3)))
typedef unsigned short bf16;
typedef unsigned v4u __attribute__((ext_vector_type(4)));
typedef float f32x4 __attribute__((ext_vector_type(4)));
typedef short bf16x8 __attribute__((ext_vector_type(8)));
typedef GAS unsigned gu32;
typedef GAS unsigned long long gu64;
#define RLX_AGENT __ATOMIC_RELAXED, __HIP_MEMORY_SCOPE_AGENT
#define LDS_WAIT() asm volatile("s_waitcnt lgkmcnt(0)" ::: "memory")
#define VM_WAIT() asm volatile("s_waitcnt vmcnt(0)" ::: "memory")
__device__ __forceinline__ unsigned long long rt() { return __builtin_amdgcn_s_memrealtime(); }
__device__ __forceinline__ unsigned f2bf(float f) { unsigned u = __builtin_bit_cast(unsigned, f); return (u + 0x7fffu + ((u >> 16) & 1u)) >> 16; }
__device__ __forceinline__ unsigned pk2(float lo, float hi) { return f2bf(lo) | (f2bf(hi) << 16); }
#define XB_TMO      128
#define XB_XCNT(j)  (256  + 64 * (j))
#define XB_XSUB(j)  (1280 + 64 * (j))
#define XB_XGEN(j)  (2304 + 64 * (j))
#define XB_TOP      3328
#define XB_TOPGEN   3392
#define XCD_BAR_WORDS 3456
#define XB_SPIN_CAP (1u << 18)

__device__ __forceinline__ unsigned xb_ld(unsigned* p)              { return __hip_atomic_load(p, __ATOMIC_RELAXED, __HIP_MEMORY_SCOPE_AGENT); }
__device__ __forceinline__ unsigned xb_add(unsigned* p, unsigned v) { return __hip_atomic_fetch_add(p, v, __ATOMIC_RELAXED, __HIP_MEMORY_SCOPE_AGENT); }
__device__ __forceinline__ unsigned xb_xcc_id() { return (unsigned)__builtin_amdgcn_s_getreg((3 << 11) | 20) & 0xFu; }
#define XB_SPIN(cond, bar) do { unsigned _sp = 0; while (cond) { __builtin_amdgcn_s_sleep(1); \
    if ((++_sp & 255u) == 0u) { if (xb_ld(&(bar)[XB_TMO])) break; if (_sp > XB_SPIN_CAP) { atomicAdd(&(bar)[XB_TMO], 1u); break; } } } } while (0)

struct XcdBarrier {
    unsigned* bar; unsigned x;
    volatile LAS unsigned* st;
};

__device__ __forceinline__ XcdBarrier xcd_barrier_post(unsigned* bar, volatile LAS unsigned* st) {
    XcdBarrier b; b.bar = bar; b.x = xb_xcc_id(); b.st = st;
    if (threadIdx.x == 0) (void)xb_add(&bar[XB_XCNT(b.x)], 1u);
    return b;
}
__device__ __forceinline__ void xcd_barrier_complete(unsigned* bar, unsigned x, unsigned& nloc, unsigned& nx) {
    const unsigned G = gridDim.x * gridDim.y * gridDim.z;
    unsigned sum, cnt, mine, sp = 0u;
    for (;;) {
        sum = 0u; cnt = 0u; mine = 0u;
#pragma unroll
        for (unsigned j = 0; j < 16; ++j) { const unsigned c = xb_ld(&bar[XB_XCNT(j)]); sum += c; cnt += (c > 0u) ? 1u : 0u; mine = (j == x) ? c : mine; }
        if (sum == G) break;
        __builtin_amdgcn_s_sleep(1);
        if ((++sp & 255u) == 0u) { if (xb_ld(&bar[XB_TMO])) break; if (sp > XB_SPIN_CAP) { atomicAdd(&bar[XB_TMO], 1u); break; } }
    }
    nloc = mine > 0u ? mine : 1u; nx = cnt > 0u ? cnt : 1u;
}

__device__ __forceinline__ void xcd_barrier(const XcdBarrier& b, int wave_id) {
    asm volatile("s_waitcnt vmcnt(0)" ::: "memory");
    __syncthreads();
    int l0_; asm volatile("v_mbcnt_lo_u32_b32 %0, -1, 0\n\tv_mbcnt_hi_u32_b32 %0, -1, %0" : "=v"(l0_));
    if (wave_id == 0 && l0_ == 0) {
        unsigned* bar = b.bar;
        __builtin_amdgcn_s_waitcnt(0);
        unsigned nloc = b.st[0], nx = b.st[1];
        if (nloc == 0u) { xcd_barrier_complete(bar, b.x, nloc, nx); b.st[0] = nloc; b.st[1] = nx; }
        const unsigned old = xb_add(&bar[XB_XSUB(b.x)], 1u);
        const unsigned gen = old / nloc;
        if (old + 1u == (gen + 1u) * nloc) {
            __builtin_amdgcn_fence(__ATOMIC_RELEASE, "agent");
            asm volatile("s_waitcnt vmcnt(0)" ::: "memory");
            const unsigned og = xb_add(&bar[XB_TOP], 1u);
            const unsigned tg = og / nx;
            if (og + 1u == (tg + 1u) * nx) xb_add(&bar[XB_TOPGEN], 1u);
            else XB_SPIN(xb_ld(&bar[XB_TOPGEN]) == tg, bar);
            __builtin_amdgcn_fence(__ATOMIC_ACQUIRE, "agent");
            xb_add(&bar[XB_XGEN(b.x)], 1u);
            asm volatile("s_waitcnt vmcnt(0)" ::: "memory");
        } else {
            XB_SPIN(xb_ld(&bar[XB_XGEN(b.x)]) == gen, bar);
            __builtin_amdgcn_fence(__ATOMIC_ACQUIRE, "agent");
            asm volatile("s_waitcnt vmcnt(0)" ::: "memory");
        }
    }
    __syncthreads();
}

constexpr int NWAVES = 8, NTHR = 512;
constexpr int NB = 8, SEQ = 2048, DM = 1024, TOK = NB * SEQ;
constexpr int IN_COLS = 6304, NWIN = 6400;
constexpr int NEXP = 16, CAP = 256, NSLOT = NB * NEXP * CAP;
constexpr float EPS = 1e-6f;
constexpr float LOG2E = 1.4426950408889634f;
typedef float f32x16 __attribute__((ext_vector_type(16)));
typedef float f32x2 __attribute__((ext_vector_type(2)));
typedef unsigned u32x2 __attribute__((ext_vector_type(2)));

constexpr size_t MiB = 1u << 20;
constexpr size_t WS_CTL = 0, CTL_ZERO_BYTES = 1 * MiB;
constexpr size_t WS_STAT = 1 * MiB;
constexpr size_t WS_SSP = 29 * MiB;
constexpr size_t WS_AFF = 2 * MiB;
constexpr size_t WS_INV = 3 * MiB;
constexpr size_t WS_SEL = 4 * MiB;
constexpr size_t WS_ROPE = 4 * MiB + 512 * 1024;
constexpr size_t WS_KT = 5 * MiB;
constexpr size_t WS_KF = 13 * MiB;
constexpr size_t WS_WIN = 32 * MiB;
constexpr size_t WS_WUQ = 45 * MiB;
constexpr size_t WS_WUKV = WS_WUQ + 512 * 256 * 2;
constexpr size_t WS_WBR = 46 * MiB;
constexpr size_t WS_WOUT = 48 * MiB;
constexpr size_t WS_WPG = 50 * MiB;
constexpr size_t WS_WPP = 52 * MiB;
constexpr size_t WS_WE1 = 54 * MiB;
constexpr size_t WS_WE2 = 118 * MiB;
constexpr size_t WS_XB = 150 * MiB;
constexpr size_t WS_PB = 182 * MiB;
constexpr size_t WS_UHYT = 190 * MiB;
constexpr size_t WS_UFNT = 214 * MiB;
constexpr size_t WS_CQ = 222 * MiB;
constexpr size_t WS_CKV = 230 * MiB;
constexpr size_t WS_NAQ = 238 * MiB;
constexpr size_t WS_NAK = 246 * MiB;
constexpr size_t WS_NAVT = 254 * MiB;
constexpr size_t WS_MPART = 190 * MiB;
constexpr size_t WS_GATES = 262 * MiB;
constexpr size_t WS_XE = 262 * MiB;
constexpr size_t WS_HB = 326 * MiB;
constexpr size_t WS_Q = 390 * MiB;
constexpr size_t WS_KFULL = 402 * MiB;
constexpr size_t WS_VT = 414 * MiB;
constexpr size_t WS_YHY = 422 * MiB, WS_YFN = 430 * MiB, WS_YMLA = 438 * MiB, WS_YNA = 446 * MiB;
constexpr size_t WS_MERGED = 454 * MiB;
constexpr size_t WS_PP = 486 * MiB;
constexpr size_t WS_END = 518 * MiB;
constexpr int CW_TMO = 0, CW_BAR = 4096;

constexpr int RING_BYTES = 131072;
constexpr int LDS_BYTES = 147456;
constexpr int LDSCTL_OFF = LDS_BYTES - 256;

struct Args {
    const float* in[30]; float* out; unsigned char* ws; int ph_lo, ph_hi, bar_idx, sub;
};
struct Frame {
    LAS unsigned char* lds;
    int tid, lane, wave, vcu, G;

};

__device__ __forceinline__ float bf2f(unsigned short h) { return __builtin_bit_cast(float, (unsigned)h << 16); }
__device__ __forceinline__ unsigned cvtpk(float lo, float hi) { return pg8::cvt_pk_bf16(lo, hi); }
__device__ __forceinline__ float shx(float v, int mask, int lane) { return __builtin_bit_cast(float, __builtin_amdgcn_ds_bpermute((lane ^ mask) << 2, __builtin_bit_cast(int, v))); }
__device__ __forceinline__ unsigned shxu(unsigned v, int mask, int lane) { return (unsigned)__builtin_amdgcn_ds_bpermute((lane ^ mask) << 2, (int)v); }
__device__ __forceinline__ float shl_from(float v, int src_lane) { return __builtin_bit_cast(float, __builtin_amdgcn_ds_bpermute(src_lane << 2, __builtin_bit_cast(int, v))); }
__device__ __forceinline__ unsigned shlu_from(unsigned v, int src_lane) { return (unsigned)__builtin_amdgcn_ds_bpermute(src_lane << 2, (int)v); }
__device__ __forceinline__ float wave_sum(float v, int lane) {
#pragma unroll
    for (int o = 1; o < 64; o <<= 1) v += shx(v, o, lane);
    return v;
}
__device__ __forceinline__ float fast_exp2(float x) { return __builtin_amdgcn_exp2f(x); }
__device__ __forceinline__ float sigmoidf_(float x) { return 1.0f / (1.0f + __expf(-x)); }

__device__ __forceinline__ int fpad(int i) { return i + (i >> 3); }
__device__ __forceinline__ f32x2 cmul(f32x2 a, f32x2 b) { return (f32x2){a.x * b.x - a.y * b.y, a.x * b.y + a.y * b.x}; }
__device__ __forceinline__ f32x2 cmulc(f32x2 a, f32x2 b) { return (f32x2){a.x * b.x + a.y * b.y, a.y * b.x - a.x * b.y}; }
template <bool INV> __device__ __forceinline__ void dft8(f32x2 (&x)[8]) {
    const float R = 0.70710678118654752f;
    f32x2 a[4], b[4];
#pragma unroll
    for (int k = 0; k < 4; ++k) { a[k] = x[k] + x[k + 4]; b[k] = x[k] - x[k + 4]; }
    if (!INV) {
        b[1] = (f32x2){(b[1].x + b[1].y) * R, (b[1].y - b[1].x) * R};
        b[2] = (f32x2){b[2].y, -b[2].x};
        b[3] = (f32x2){(-b[3].x + b[3].y) * R, (-b[3].x - b[3].y) * R};
    } else {
        b[1] = (f32x2){(b[1].x - b[1].y) * R, (b[1].x + b[1].y) * R};
        b[2] = (f32x2){-b[2].y, b[2].x};
        b[3] = (f32x2){(-b[3].x - b[3].y) * R, (b[3].x - b[3].y) * R};
    }
    {
        f32x2 e0 = a[0] + a[2], e1 = a[0] - a[2], f0 = a[1] + a[3], d = a[1] - a[3];
        f32x2 f1 = INV ? (f32x2){-d.y, d.x} : (f32x2){d.y, -d.x};
        x[0] = e0 + f0; x[2] = e1 + f1; x[4] = e0 - f0; x[6] = e1 - f1;
    }
    {
        f32x2 e0 = b[0] + b[2], e1 = b[0] - b[2], f0 = b[1] + b[3], d = b[1] - b[3];
        f32x2 f1 = INV ? (f32x2){-d.y, d.x} : (f32x2){d.y, -d.x};
        x[1] = e0 + f0; x[3] = e1 + f1; x[5] = e0 - f0; x[7] = e1 - f1;
    }
}
template <int S> __device__ __forceinline__ const LAS f32x2* fft_wp(const LAS f32x2* tw, int j) { return S == 0 ? tw + j : (S == 1 ? tw + 3584 + j : tw + 4032 + j); }
template <int S> __device__ __forceinline__ void fft_stage_fwd(LAS f32x2* buf, const LAS f32x2* tw, int tid) {
    constexpr int q = 512 >> (3 * S), n = 8 * q;
    const int blk = tid / q, j = tid % q, base = blk * n + j;
    f32x2 x[8];
#pragma unroll
    for (int k = 0; k < 8; ++k) x[k] = buf[fpad(base + k * q)];
    dft8<false>(x);
    if (S < 3) { const LAS f32x2* wp = fft_wp<S>(tw, j);
#pragma unroll
        for (int m = 1; m < 8; ++m) x[m] = cmul(x[m], wp[(m - 1) * q]); }
#pragma unroll
    for (int k = 0; k < 8; ++k) buf[fpad(base + k * q)] = x[k];
}
template <int S> __device__ __forceinline__ void fft_stage_inv(LAS f32x2* buf, const LAS f32x2* tw, int tid) {
    constexpr int q = 512 >> (3 * S), n = 8 * q;
    const int blk = tid / q, j = tid % q, base = blk * n + j;
    f32x2 x[8];
#pragma unroll
    for (int k = 0; k < 8; ++k) x[k] = buf[fpad(base + k * q)];
    if (S < 3) { const LAS f32x2* wp = fft_wp<S>(tw, j);
#pragma unroll
        for (int m = 1; m < 8; ++m) x[m] = cmulc(x[m], wp[(m - 1) * q]); }
    dft8<true>(x);
#pragma unroll
    for (int k = 0; k < 8; ++k) buf[fpad(base + k * q)] = x[k];
}
__device__ __forceinline__ void fft_fwd(LAS f32x2* buf, const LAS f32x2* tw, int tid) {
    fft_stage_fwd<0>(buf, tw, tid); __syncthreads();
    fft_stage_fwd<1>(buf, tw, tid); __syncthreads();
    fft_stage_fwd<2>(buf, tw, tid); __syncthreads();
    fft_stage_fwd<3>(buf, tw, tid); __syncthreads();
}
__device__ __forceinline__ void fft_inv(LAS f32x2* buf, const LAS f32x2* tw, int tid) {
    fft_stage_inv<3>(buf, tw, tid); __syncthreads();
    fft_stage_inv<2>(buf, tw, tid); __syncthreads();
    fft_stage_inv<1>(buf, tw, tid); __syncthreads();
    fft_stage_inv<0>(buf, tw, tid); __syncthreads();
}
__device__ __forceinline__ void fft_fwd2(LAS f32x2* b0, LAS f32x2* b1, const LAS f32x2* tw, int tid) {
    fft_stage_fwd<0>(b0, tw, tid); fft_stage_fwd<0>(b1, tw, tid); __syncthreads();
    fft_stage_fwd<1>(b0, tw, tid); fft_stage_fwd<1>(b1, tw, tid); __syncthreads();
    fft_stage_fwd<2>(b0, tw, tid); fft_stage_fwd<2>(b1, tw, tid); __syncthreads();
    fft_stage_fwd<3>(b0, tw, tid); fft_stage_fwd<3>(b1, tw, tid); __syncthreads();
}
__device__ __forceinline__ void fft_inv2(LAS f32x2* b0, LAS f32x2* b1, const LAS f32x2* tw, int tid) {
    fft_stage_inv<3>(b0, tw, tid); fft_stage_inv<3>(b1, tw, tid); __syncthreads();
    fft_stage_inv<2>(b0, tw, tid); fft_stage_inv<2>(b1, tw, tid); __syncthreads();
    fft_stage_inv<1>(b0, tw, tid); fft_stage_inv<1>(b1, tw, tid); __syncthreads();
    fft_stage_inv<0>(b0, tw, tid); fft_stage_inv<0>(b1, tw, tid); __syncthreads();
}
__device__ __forceinline__ int digrev(int f) { return ((f & 7) << 9) | (((f >> 3) & 7) << 6) | (((f >> 6) & 7) << 3) | ((f >> 9) & 7); }
constexpr int FFT_BUF_OFF = 0, FFT_BUF1_OFF = 36864, FFT_TW_OFF = 73728, FFT_STAGE_OFF = 106496;
__device__ __forceinline__ void fft_init_tw(const Args& A, Frame& F) {
    LAS f32x2* tw = (LAS f32x2*)(F.lds + FFT_TW_OFF);
    for (int k = F.tid; k < 4088; k += NTHR) { int jm; float sc;
        if (k < 3584) { jm = (k & 511) * ((k >> 9) + 1); sc = 1.0f / 2048.0f; } else if (k < 4032) { const int r = k - 3584; jm = (r & 63) * ((r >> 6) + 1); sc = 1.0f / 256.0f; } else { const int r = k - 4032; jm = (r & 7) * ((r >> 3) + 1); sc = 1.0f / 32.0f; }
        float s, c; sincospif((float)jm * sc, &s, &c); tw[k] = (f32x2){c, -s}; }
    __syncthreads();
}

__device__ __forceinline__ void phase_p0(const Args& A, Frame& F) {
    unsigned char* wsl = A.ws; asm volatile("" : "+s"(wsl));
    const float* x = A.in[0]; float* ss = (float*)(wsl + WS_STAT); bf16* xb = (bf16*)(wsl + WS_XB);
    const int gw = F.vcu * NWAVES + F.wave, NGW = F.G * NWAVES;
    for (int row = gw; row < TOK; row += NGW) {
        const f32x4* xr = (const f32x4*)(x + (size_t)row * DM) + F.lane;
        u32x2* brow = (u32x2*)(xb + (size_t)row * DM) + F.lane;
        float s = 0.f;
#pragma unroll
        for (int j = 0; j < 4; ++j) { const f32x4 v = xr[64 * j]; s += (v.x * v.x + v.y * v.y) + (v.z * v.z + v.w * v.w); brow[64 * j] = (u32x2){cvtpk(v.x, v.y), cvtpk(v.z, v.w)}; }
        s = wave_sum(s, F.lane);
        if (F.lane == 0) ss[row] = s;
    }
    float* rc = (float*)(wsl + WS_ROPE);
    for (int i = F.vcu * NTHR + F.tid; i < SEQ * 16; i += F.G * NTHR) { const float invf = exp2f(-(float)(i & 15) * (13.287712379549449f / 16.0f)); float sn, cs; sincosf((float)(i >> 4) * invf, &sn, &cs); rc[i] = cs; rc[SEQ * 16 + i] = sn; }
}

__device__ __forceinline__ void tr_item(const float* W, int ldw, const float* g, float cs, bf16* WT, int ldt, int k0, int sn0, int dn0, LAS float* scr, int lane) {
#pragma unroll 8
    for (int i = 0; i < 32; ++i) { const int kk = 2 * i + (lane >> 5); const float gv = g ? g[k0 + kk] * cs : cs;
        scr[kk * 33 + (lane & 31)] = W[(size_t)(k0 + kk) * ldw + sn0 + (lane & 31)] * gv; }
    LDS_WAIT(); asm volatile("" ::: "memory");
    const int c = lane & 7;
#pragma unroll
    for (int j = 0; j < 4; ++j) { const int n = (lane >> 3) + 8 * j; const LAS float* s = scr + (8 * c) * 33 + n;
        v4u o; o.x = cvtpk(s[0 * 33], s[1 * 33]); o.y = cvtpk(s[2 * 33], s[3 * 33]); o.z = cvtpk(s[4 * 33], s[5 * 33]); o.w = cvtpk(s[6 * 33], s[7 * 33]);
        *(v4u*)(WT + (size_t)(dn0 + n) * ldt + k0 + 8 * c) = o; }
    LDS_WAIT(); asm volatile("" ::: "memory");
}
__device__ __forceinline__ void tr_item64(const float* W, int ldw, const float* g, bf16* WT, int ldt, int k0, int sn0, int dn0, LAS unsigned char* scr, int lane) {
    const int r2 = lane >> 4, c = lane & 15;
    const float* wp = W + (size_t)(k0 + 2 * r2) * ldw + sn0 + 4 * c;
    f32x4 v0[8], v1[8];
#pragma unroll
    for (int i = 0; i < 8; ++i) { v0[i] = *(const f32x4*)(wp + (size_t)(8 * i) * ldw); v1[i] = *(const f32x4*)(wp + (size_t)(8 * i + 1) * ldw); }
#pragma unroll
    for (int i = 0; i < 8; ++i) { const int k = 8 * i + 2 * r2; float g0 = 1.f, g1 = 1.f; if (g) { g0 = g[k0 + k]; g1 = g[k0 + k + 1]; }
#pragma unroll
        for (int j = 0; j < 4; ++j) { const int n = 4 * c + j;
            *(LAS unsigned*)(scr + n * 128 + (((k >> 3) ^ (c & 7)) << 4) + (k & 7) * 2) = cvtpk(v0[i][j] * g0, v1[i][j] * g1); } }
    LDS_WAIT(); asm volatile("" ::: "memory");
    const int ch = lane & 7;
#pragma unroll
    for (int jj = 0; jj < 8; ++jj) { const int n = (lane >> 3) + 8 * jj;
        const v4u o = *(const LAS v4u*)(scr + n * 128 + ((ch ^ ((n >> 2) & 7)) << 4));
        *(v4u*)(WT + (size_t)(dn0 + n) * ldt + k0 + 8 * ch) = o; }
    LDS_WAIT(); asm volatile("" ::: "memory");
}
__device__ __forceinline__ void tr_item_wg(const float* W, int ldw, const float* g, bf16* WT, int ldt, int k0, int sn0, int dnA, int dnB, LAS unsigned char* lds, int tid) {
    const int c = tid & 63, r = tid >> 6;
    const float* wp = W + (size_t)(k0 + 2 * r) * ldw + sn0 + 4 * c;
    f32x4 v0[8], v1[8];
#pragma unroll
    for (int i = 0; i < 8; ++i) { v0[i] = *(const f32x4*)(wp + (size_t)(16 * i) * ldw); v1[i] = *(const f32x4*)(wp + (size_t)(16 * i + 1) * ldw); }
#pragma unroll
    for (int i = 0; i < 8; ++i) { const int k = 16 * i + 2 * r; float g0 = 1.f, g1 = 1.f; if (g) { g0 = g[k0 + k]; g1 = g[k0 + k + 1]; }
#pragma unroll
        for (int j = 0; j < 4; ++j) *(LAS unsigned*)(lds + (4 * c + j) * 256 + (((k >> 3) ^ (c & 15)) << 4) + (k & 7) * 2) = cvtpk(v0[i][j] * g0, v1[i][j] * g1); }
    __syncthreads();
    const int ch = tid & 15;
#pragma unroll
    for (int jj = 0; jj < 8; ++jj) { const int n = (tid >> 4) + 32 * jj;
        const v4u o = *(const LAS v4u*)(lds + n * 256 + ((ch ^ ((n >> 2) & 15)) << 4));
        *(v4u*)(WT + (size_t)(n < 128 ? dnA + n : dnB + n - 128) * ldt + k0 + 8 * ch) = o; }
    __syncthreads();
}
__device__ __forceinline__ void fn_fold_item(const float* W, const float* g1, bf16* WT, int k0, int grp, LAS float* scr, int lane) {
    LAS float* tab = scr + 8 * 64;
    { float s, co; sincospif((float)lane * (1.0f / 32.0f), &s, &co); tab[lane] = co; }
#pragma unroll
    for (int i = 0; i < 8; ++i) scr[i * 64 + lane] = W[(size_t)(k0 + i) * IN_COLS + 768 + 64 * grp + lane] * g1[k0 + i];
    LDS_WAIT(); asm volatile("" ::: "memory");
    const int j = lane, m = j <= 32 ? j : j - 32; const float sc = (j <= 32 ? 1.0f : -1.0f) / 362.03867196751236f;
    const int sh = j <= 32 ? 0 : 48;
    float a[8];
#pragma unroll
    for (int q = 0; q < 8; ++q) a[q] = 0.f;
#pragma unroll 4
    for (int c = 0; c < 64; c += 4) { float d[4];
#pragma unroll
        for (int e = 0; e < 4; ++e) d[e] = tab[(m * (c + e) + sh) & 63];
#pragma unroll
        for (int q = 0; q < 8; ++q) { const f32x4 sv = *(const LAS f32x4*)(scr + q * 64 + c); a[q] += (sv.x * d[0] + sv.y * d[1]) + (sv.z * d[2] + sv.w * d[3]); } }
    v4u o; o.x = cvtpk(a[0] * sc, a[1] * sc); o.y = cvtpk(a[2] * sc, a[3] * sc); o.z = cvtpk(a[4] * sc, a[5] * sc); o.w = cvtpk(a[6] * sc, a[7] * sc);
    *(v4u*)(WT + (size_t)(768 + 64 * grp + j) * DM + k0) = o;
    LDS_WAIT(); asm volatile("" ::: "memory");
}
__device__ __forceinline__ void phase_l0a(const Args& A, Frame& F, int li) {
    unsigned char* wsl = A.ws; asm volatile("" : "+s"(wsl));
    LAS float* scr = (LAS float*)(F.lds + F.wave * 16384);
    const int gw = F.vcu * NWAVES + F.wave, NGW = F.G * NWAVES, lane = F.lane;
    const float* w_in = A.in[3] + (size_t)li * DM * IN_COLS; const float* g1 = A.in[2] + li * DM;
    const float* w_uq = A.in[15] + (size_t)li * 256 * 384; const float* qg = A.in[14] + li * 256;
    const float* w_ukv = A.in[17] + (size_t)li * 128 * 512; const float* kvg = A.in[16] + li * 128;
    const float* w_br = A.in[19] + (size_t)li * 4 * 256 * DM; const float* w_out = A.in[20] + (size_t)li * DM * DM;
    const float* g2 = A.in[21] + li * DM; const float* w_eg = A.in[23] + (size_t)li * NEXP * DM * DM; const float* w_eu = A.in[24] + (size_t)li * NEXP * DM * DM;
    const float* w_ed = A.in[25] + (size_t)li * NEXP * DM * DM; const float* g3 = A.in[26] + li * DM;
    const float* w_pg = A.in[27] + (size_t)li * DM * DM; const float* w_pp = A.in[28] + (size_t)li * 256 * DM;
    bf16* WIN = (bf16*)(wsl + WS_WIN); bf16* WUQ = (bf16*)(wsl + WS_WUQ); bf16* WUKV = (bf16*)(wsl + WS_WUKV); bf16* WBR = (bf16*)(wsl + WS_WBR);
    bf16* WOUT = (bf16*)(wsl + WS_WOUT); bf16* WPG = (bf16*)(wsl + WS_WPG); bf16* WPP = (bf16*)(wsl + WS_WPP); bf16* WE1 = (bf16*)(wsl + WS_WE1); bf16* WE2 = (bf16*)(wsl + WS_WE2);
    constexpr int W_E = 32, NWG_ITEMS = (NEXP * 3 + 2) * W_E;
    const int sub_ = A.sub;
    if (sub_ == 0 || sub_ == 1)
    for (int it = blockIdx.x; it < NWG_ITEMS; it += F.G) {
        const int mat = it / W_E, q = it % W_E, kb = q >> 2, nb = q & 3, f0 = 256 * nb;
        if (mat < NEXP * 2) { const int e = mat >> 1, up = mat & 1; const int dnA = 256 * (f0 >> 7) + 128 * up;
            tr_item_wg((up ? w_eu : w_eg) + (size_t)e * DM * DM, DM, g2, WE1 + (size_t)e * 2048 * DM, DM, 128 * kb, f0, dnA, dnA + 256, F.lds, F.tid); }
        else if (mat < NEXP * 3) { const int e = mat - NEXP * 2; tr_item_wg(w_ed + (size_t)e * DM * DM, DM, nullptr, WE2 + (size_t)e * DM * DM, DM, 128 * kb, f0, f0, f0 + 128, F.lds, F.tid); }
        else if (mat == NEXP * 3) tr_item_wg(w_out, DM, nullptr, WOUT, DM, 128 * kb, f0, f0, f0 + 128, F.lds, F.tid);
        else tr_item_wg(w_pg, DM, g3, WPG, DM, 128 * kb, f0, f0, f0 + 128, F.lds, F.tid);
    }
    constexpr int I_IN = 16 * 99, I_UQ = 4 * 12, I_UKV = 2 * 16, I_BR = 4 * 4 * 16, I_PP = 4 * 16, I_FN = 512;
    constexpr int NITEMS = I_IN + I_UQ + I_UKV + I_BR + I_PP + I_FN;
    LAS unsigned char* scr8 = (LAS unsigned char*)scr;
    if (sub_ == 0 || sub_ == 2)
    for (int it = gw; it < NITEMS; it += NGW) {
        int r = it;
        if (r < I_IN) { const int kb = r / 99, nb = r % 99;
            if (nb < 12) tr_item64(w_in, IN_COLS, g1, WIN, DM, 64 * kb, 64 * nb, 64 * nb, scr8, lane);
            else if (nb < 18) tr_item64(w_in, IN_COLS, g1, WIN, DM, 64 * kb, 1024 + 64 * (nb - 12), 1024 + 64 * (nb - 12), scr8, lane);
            else if (nb == 18) tr_item(w_in, IN_COLS, g1, 1.f, WIN, DM, 64 * kb, 1408, 1408, scr, lane);
            else if (nb < 31) tr_item64(w_in, IN_COLS, g1, WIN, DM, 64 * kb, 1440 + 64 * (nb - 19), 1536 + 64 * (nb - 19), scr8, lane);
            else if (nb < 95) tr_item64(w_in, IN_COLS, g1, WIN, DM, 64 * kb, 2208 + 64 * (nb - 31), 2304 + 64 * (nb - 31), scr8, lane);
            continue; }
        r -= I_IN;
        if (r < I_UQ) { const int kb = r / 12, nb = r % 12; tr_item(w_uq, 384, qg, 0.10206207261596577f * LOG2E, WUQ, 256, 64 * kb, 32 * nb, 32 * nb, scr, lane); continue; }
        r -= I_UQ;
        if (r < I_UKV) { const int kb = r / 16, nb = r % 16; tr_item(w_ukv, 512, kvg, 1.f, WUKV, 256, 64 * kb, 32 * nb, 32 * nb, scr, lane); continue; }
        r -= I_UKV;
        if (r < I_BR) { const int n = r / 64, q2 = r % 64, kb = q2 / 16, nb = q2 % 16; tr_item64(w_br + (size_t)n * 256 * DM, DM, nullptr, WBR + (size_t)n * DM * 256, 256, 64 * kb, 64 * nb, 64 * nb, scr8, lane); continue; }
        r -= I_BR;
        if (r < I_PP) { const int kb = r / 16, nb = r % 16; tr_item64(w_pp, DM, nullptr, WPP, 256, 64 * kb, 64 * nb, 64 * nb, scr8, lane); continue; }
        r -= I_PP;
        fn_fold_item(w_in, g1, WIN, 8 * (r >> 2), r & 3, scr, lane);
    }
    if (sub_ == 0 || sub_ == 3) {
    const int gt = F.vcu * NTHR + F.tid, NGT = F.G * NTHR;
    unsigned zz_ = 0u; asm volatile("" : "+v"(zz_)); const v4u z4 = (v4u){zz_, zz_, zz_, zz_};
    for (int i = gt; i < 96 * 1024 / 8; i += NGT) ((v4u*)(WIN + (size_t)1440 * DM))[i] = z4;
    for (int i = gt; i < 128 * 256 / 8; i += NGT) ((v4u*)(WUQ + (size_t)384 * 256))[i] = z4;
    for (int i = gt; i < 512 * 16; i += NGT) ((v4u*)(WUKV + (size_t)(i >> 4) * 256 + 128))[i & 15] = z4;
    float* st = (float*)(wsl + WS_STAT);
    if (li > 0) { const f32x4* sp = (const f32x4*)(wsl + WS_SSP);
        for (int i = gt; i < TOK; i += NGT) { const f32x4 p0 = sp[4 * i], p1 = sp[4 * i + 1], p2 = sp[4 * i + 2], p3 = sp[4 * i + 3];
            st[(size_t)li * TOK + i] = (((p0.x + p0.y) + (p0.z + p0.w)) + ((p1.x + p1.y) + (p1.z + p1.w))) + (((p2.x + p2.y) + (p2.z + p2.w)) + ((p3.x + p3.y) + (p3.z + p3.w))); } }
    const f32x4* p4 = (const f32x4*)(A.in[1] + (size_t)li * TOK * 256); u32x2* pb = (u32x2*)(wsl + WS_PB);
    for (int i = gt; i < TOK * 256 / 4; i += NGT) { const f32x4 v = p4[i]; pb[i] = (u32x2){cvtpk(v.x, v.y), cvtpk(v.z, v.w)}; }
    }
    __syncthreads();
    if (sub_ == 0 || sub_ == 4) {
        LAS float* zs = (LAS float*)F.lds; LAS float* h1s = zs + 8 * 36; LAS float* h2s = h1s + 8 * 64;
        const float* w1 = A.in[7] + li * 33 * 64; const float* b1 = A.in[8] + li * 64; const float* fr = A.in[9] + li * 128;
        const float* w2 = A.in[10] + li * 64 * 64; const float* b2 = A.in[11] + li * 64; const float* w3 = A.in[12] + (size_t)li * 64 * 1024;
        float* KT = (float*)(wsl + WS_KT);
        const int tid = F.tid;
        for (int u = blockIdx.x; u < 256; u += F.G) {
            const int l0 = 8 * u;
            if (tid < 8 * 33) { const int p = tid / 33, i = tid % 33, l = l0 + p; float v;
                if (i == 0) v = (float)l / 2047.0f;
                else { const int b = (i - 1) & 15; const float band = 1e-4f + (float)b * ((15.0f - 1e-4f) / 15.0f); const float ang = ((6.283185307179586f * (float)l) * band) / 2048.0f;
                    float s, c; sincosf(ang, &s, &c); v = (i <= 16) ? c : -s; }
                zs[p * 36 + i] = v; }
            __syncthreads();
            { const int p = tid >> 6, j = tid & 63; float a = b1[j];
#pragma unroll
                for (int i = 0; i < 33; ++i) a += zs[p * 36 + i] * w1[i * 64 + j];
                h1s[p * 64 + j] = sinf(fr[j] * a); }
            __syncthreads();
            { const int p = tid >> 6, j = tid & 63; float a = b2[j];
#pragma unroll 16
                for (int i = 0; i < 64; ++i) a += h1s[p * 64 + i] * w2[i * 64 + j];
                h2s[p * 64 + j] = sinf(fr[64 + j] * a); }
            __syncthreads();
#pragma unroll
            for (int cc = 0; cc < 2; ++cc) { const int col = tid + 512 * cc; float a[8];
#pragma unroll
                for (int p = 0; p < 8; ++p) a[p] = 0.f;
#pragma unroll 4
                for (int i = 0; i < 64; i += 4) { const float w0 = w3[i * 1024 + col], w1_ = w3[(i + 1) * 1024 + col], w2_ = w3[(i + 2) * 1024 + col], w3_ = w3[(i + 3) * 1024 + col];
#pragma unroll
                    for (int p = 0; p < 8; ++p) { const f32x4 hv = *(const LAS f32x4*)(h2s + p * 64 + i); a[p] += (hv.x * w0 + hv.y * w1_) + (hv.z * w2_ + hv.w * w3_); } }
                const int o = col >> 9, dir = (col >> 8) & 1, c = col & 255;
                const float mind = -3.0701134573253945f, maxd = -15.350567286626973f;
                const float ad = fabsf(mind + (float)c * ((maxd - mind) / 255.0f));
                float* kt = KT + (size_t)(o * 256 + c) * 4096;
#pragma unroll
                for (int p = 0; p < 8; ++p) { const int l = l0 + p; const float wv = a[p] * __expf(-((float)l / 2047.0f) * ad);
                    if (dir == 0) kt[l] = wv; else if (l > 0) kt[4096 - l] = wv; }
                if (u == 0 && dir == 0) kt[2048] = 0.f; }
            __syncthreads();
        }
    }
}
__device__ __forceinline__ void filter_fft(const Args& A, Frame& F, int cc, int GG) {
    unsigned char* wsl = A.ws; asm volatile("" : "+s"(wsl));
    LAS f32x2* buf = (LAS f32x2*)(F.lds + FFT_BUF_OFF); const LAS f32x2* tw = (const LAS f32x2*)(F.lds + FFT_TW_OFF); LAS float* red = (LAS float*)(F.lds + FFT_STAGE_OFF);
    const float* KT = (const float*)(wsl + WS_KT); f32x2* KF = (f32x2*)(wsl + WS_KF);
    fft_init_tw(A, F);
    for (int u = cc; u < 512; u += GG) {
        const float* kt = KT + (size_t)u * 4096; float v[8]; float s = 0.f;
#pragma unroll
        for (int k = 0; k < 8; ++k) { v[k] = kt[F.tid + 512 * k]; s += v[k] * v[k]; }
        s = wave_sum(s, F.lane);
        if (F.lane == 0) red[F.wave] = s;
        __syncthreads();
        float tot = 0.f;
#pragma unroll
        for (int w = 0; w < 8; ++w) tot += red[w];
        const float sc = rsqrtf(tot + EPS) * (1.0f / 4096.0f);
#pragma unroll
        for (int k = 0; k < 8; ++k) buf[fpad(F.tid + 512 * k)] = (f32x2){v[k] * sc, 0.f};
        __syncthreads();
        fft_fwd(buf, tw, F.tid);
#pragma unroll
        for (int k = 0; k < 8; ++k) KF[(size_t)u * 4096 + F.tid + 512 * k] = buf[fpad(F.tid + 512 * k)];
        __syncthreads();
    }
}
#ifndef MK_DROP
#define MK_DROP 0
#endif

typedef const f32x4 (&AccRef)[2][2][4][2];
__device__ __forceinline__ void st_bf16x4(bf16* p, f32x4 v) { *(u32x2*)p = (u32x2){cvtpk(v.x, v.y), cvtpk(v.z, v.w)}; }
__device__ __forceinline__ f32x4 ld_bf16x4(const bf16* p) { const u32x2 w = *(const u32x2*)p;
    return (f32x4){__builtin_bit_cast(float, w.x << 16), __builtin_bit_cast(float, w.x & 0xffff0000u), __builtin_bit_cast(float, w.y << 16), __builtin_bit_cast(float, w.y & 0xffff0000u)}; }

__device__ __forceinline__ unsigned llt_lane(int wr, int wc, int fr, int fq) { return (unsigned)(((wr * 4 + wc) * 64 + fq * 16 + fr) * 4); }
__device__ __forceinline__ unsigned llt_q(int ai, int bj, int m, int n) { return (unsigned)((((ai * 2 + bj) * 4 + m) * 2 + n) * 2048); }
struct EpiWin {
    static constexpr bool PERM = false, AFTER_DRAIN = false;
    const float* ss1; const float* bgate; unsigned char* ws;
    __device__ __forceinline__ void operator()(AccRef acc, const pg8::Unit& u, int wr, int wc, int fr, int fq) const {
        asm volatile("" : "+v"(fr), "+v"(fq));
        const int pn = u.pn, row0 = u.pm * 256 + wr * 64 + fr;
        float rs[2][4];
#pragma unroll
        for (int ai = 0; ai < 2; ++ai)
#pragma unroll
            for (int m = 0; m < 4; ++m) rs[ai][m] = rsqrtf(ss1[row0 + ai * 128 + m * 16] * (1.0f / 1024.0f) + EPS);
        if (pn >= 9) {
            unsigned char* G = (unsigned char*)(ws + WS_GATES) + (size_t)(u.pm * 16 + (pn - 9)) * 65536; const int cg0 = 256 * (pn - 9) + 32 * wc + 4 * fq; const unsigned ll = llt_lane(wr, wc, fr, fq);
#pragma unroll
            for (int bj = 0; bj < 2; ++bj)
#pragma unroll
                for (int n = 0; n < 2; ++n) { const int cg = cg0 + 128 * bj + 16 * n; const f32x4 bv = *(const f32x4*)(bgate + cg); unsigned lo = ll; asm volatile("" : "+v"(lo));
#pragma unroll
                    for (int ai = 0; ai < 2; ++ai)
#pragma unroll
                        for (int m = 0; m < 4; ++m) { const f32x4 a = acc[ai][bj][m][n] * rs[ai][m] + bv;
                            const unsigned q0 = (unsigned)(sigmoidf_(a.x) * 255.0f + 0.5f), q1 = (unsigned)(sigmoidf_(a.y) * 255.0f + 0.5f), q2 = (unsigned)(sigmoidf_(a.z) * 255.0f + 0.5f), q3 = (unsigned)(sigmoidf_(a.w) * 255.0f + 0.5f);
                            *(unsigned*)(G + (lo + llt_q(ai, bj, m, n))) = q0 | (q1 << 8) | (q2 << 16) | (q3 << 24); } }
        } else if (pn <= 3 || pn == 8) {
            bf16* D; int NC, ct0;
            if (pn <= 2) { D = (bf16*)(ws + WS_UHYT); NC = 768; ct0 = 256 * pn; } else if (pn == 3) { D = (bf16*)(ws + WS_UFNT); NC = 256; ct0 = 0; } else { D = (bf16*)(ws + WS_NAVT); NC = 256; ct0 = 0; }
            const int b = row0 >> 11, l0 = row0 & 2047;
#pragma unroll
            for (int bj = 0; bj < 2; ++bj)
#pragma unroll
                for (int n = 0; n < 2; ++n) { const int ct = ct0 + 128 * bj + 32 * wc + 16 * n + 4 * fq; bf16* dp = D + ((size_t)(b * NC + ct)) * 2048 + l0;
#pragma unroll
                    for (int ai = 0; ai < 2; ++ai)
#pragma unroll
                        for (int m = 0; m < 4; ++m) { const f32x4 a = acc[ai][bj][m][n] * rs[ai][m]; bf16* q = dp + ai * 128 + m * 16;
                            const unsigned w0 = cvtpk(a.x, a.y), w1 = cvtpk(a.z, a.w);
                            q[0] = (bf16)w0; q[2048] = (bf16)(w0 >> 16); q[4096] = (bf16)w1; q[6144] = (bf16)(w1 >> 16); } }
        } else {
            bf16* D = (bf16*)(ws + (pn == 4 ? WS_CQ : pn == 5 ? WS_CKV : pn == 6 ? WS_NAQ : WS_NAK));
            const float csc = (pn == 6) ? 0.125f * LOG2E : 1.0f;
            float* ssx = (float*)(ws + WS_STAT) + (size_t)(pn == 4 ? 7 : 11) * TOK;
#pragma unroll
            for (int ai = 0; ai < 2; ++ai)
#pragma unroll
                for (int m = 0; m < 4; ++m) { const int row = row0 + ai * 128 + m * 16; float s = 0.f;
#pragma unroll
                    for (int bj = 0; bj < 2; ++bj)
#pragma unroll
                        for (int n = 0; n < 2; ++n) { const f32x4 a = acc[ai][bj][m][n] * (rs[ai][m] * csc);
                            st_bf16x4(D + (size_t)row * 256 + 128 * bj + 32 * wc + 16 * n + 4 * fq, a);
                            if (pn == 4 || (pn == 5 && bj == 0)) s += (a.x * a.x + a.y * a.y) + (a.z * a.z + a.w * a.w); }
                    if (pn == 4 || pn == 5) { s += shx(s, 16, fq * 16 + fr); s += shx(s, 32, fq * 16 + fr); if (fq == 0) ssx[(size_t)row * 4 + wc] = s; }
                    if (pn == 5 && wc == 0) {
                        const f32x4 x1 = acc[ai][1][m][0] * rs[ai][m], x2 = acc[ai][1][m][1] * rs[ai][m]; const float* rc = (const float*)(ws + WS_ROPE) + (row & 2047) * 16 + 4 * fq;
                        const f32x4 cs = *(const f32x4*)rc, sn = *(const f32x4*)(rc + SEQ * 16); const f32x4 o1 = x1 * cs - x2 * sn, o2 = x2 * cs + x1 * sn;
                        bf16* kf = (bf16*)(ws + WS_KFULL) + (size_t)row * 384 + 64 + 4 * fq;
#pragma unroll
                        for (int h = 0; h < 4; ++h) { st_bf16x4(kf + h * 96, o1); st_bf16x4(kf + h * 96 + 16, o2); }
                    } }
        }
    }
};
struct EpiQ {
    static constexpr bool PERM = false, AFTER_DRAIN = false;
    unsigned char* ws;
    __device__ __forceinline__ void operator()(AccRef acc, const pg8::Unit& u, int wr, int wc, int fr, int fq) const {
        const float* ssq = (const float*)(ws + WS_STAT) + (size_t)7 * TOK; bf16* Q = (bf16*)(ws + WS_Q);
        const int row0 = u.pm * 256 + wr * 64 + fr;
        float rq[2][4];
#pragma unroll
        for (int ai = 0; ai < 2; ++ai)
#pragma unroll
            for (int m = 0; m < 4; ++m) { const f32x4 pq = *(const f32x4*)(ssq + (size_t)(row0 + ai * 128 + m * 16) * 4); rq[ai][m] = rsqrtf(((pq.x + pq.y) + (pq.z + pq.w)) * (1.0f / 256.0f) + EPS); }
#pragma unroll
        for (int bj = 0; bj < 2; ++bj) { const int gb = 256 * u.pn + 128 * bj + 32 * wc; if (gb >= 384) continue; const bool rope = (gb % 96) == 64;
#pragma unroll
            for (int ai = 0; ai < 2; ++ai)
#pragma unroll
                for (int m = 0; m < 4; ++m) { const int row = row0 + ai * 128 + m * 16; const float r = rq[ai][m];
                    f32x4 o1 = acc[ai][bj][m][0] * r, o2 = acc[ai][bj][m][1] * r;
                    if (rope) { const f32x4 x1 = o1, x2 = o2; const float* rc = (const float*)(ws + WS_ROPE) + (row & 2047) * 16 + 4 * fq;
                        const f32x4 cs = *(const f32x4*)rc, sn = *(const f32x4*)(rc + SEQ * 16); o1 = x1 * cs - x2 * sn; o2 = x2 * cs + x1 * sn; }
                    st_bf16x4(Q + (size_t)row * 384 + gb + 4 * fq, o1); st_bf16x4(Q + (size_t)row * 384 + gb + 16 + 4 * fq, o2); if (m == 3) asm volatile("" ::: "memory"); } }
    }
};
struct EpiKV {
    static constexpr bool PERM = false, AFTER_DRAIN = false;
    unsigned char* ws;
    __device__ __forceinline__ void operator()(AccRef acc, const pg8::Unit& u, int wr, int wc, int fr, int fq) const {
        const float* sskv = (const float*)(ws + WS_STAT) + (size_t)11 * TOK; bf16* KFU = (bf16*)(ws + WS_KFULL); bf16* VT = (bf16*)(ws + WS_VT);
        const int row0 = u.pm * 256 + wr * 64 + fr;
        float rq[2][4];
#pragma unroll
        for (int ai = 0; ai < 2; ++ai)
#pragma unroll
            for (int m = 0; m < 4; ++m) { const f32x4 pq = *(const f32x4*)(sskv + (size_t)(row0 + ai * 128 + m * 16) * 4); rq[ai][m] = rsqrtf(((pq.x + pq.y) + (pq.z + pq.w)) * (1.0f / 128.0f) + EPS); }
#pragma unroll
        for (int ai = 0; ai < 2; ++ai)
#pragma unroll
            for (int m = 0; m < 4; ++m) { const int row = row0 + ai * 128 + m * 16; const float r = rq[ai][m]; const int b = row >> 11, l = row & 2047;
#pragma unroll
                for (int bj = 0; bj < 2; ++bj) { const int h = 2 * u.pn + bj;
#pragma unroll
                    for (int n = 0; n < 2; ++n) { const f32x4 a = acc[ai][bj][m][n] * r; const int within = 32 * wc + 16 * n + 4 * fq;
                        if (wc < 2) st_bf16x4(KFU + (size_t)row * 384 + h * 96 + within, a);
                        else { bf16* q = VT + ((size_t)((b * 4 + h) * 64 + (within - 64))) * 2048 + l; const unsigned w0 = cvtpk(a.x, a.y), w1 = cvtpk(a.z, a.w);
                            q[0] = (bf16)w0; q[2048] = (bf16)(w0 >> 16); q[4096] = (bf16)w1; q[6144] = (bf16)(w1 >> 16); } } }
                asm volatile("" ::: "memory"); }
    }
};
struct EpiBranch {
    static constexpr bool PERM = false, AFTER_DRAIN = false;
    unsigned char* ws;
    __device__ __forceinline__ void operator()(AccRef acc, const pg8::Unit& u, int wr, int wc, int fr, int fq) const {
        const int n = u.aux; const unsigned char* G = (const unsigned char*)(ws + WS_GATES) + (size_t)(u.pm * 16 + n * 4 + u.pn) * 65536; bf16* MP = (bf16*)(ws + WS_MPART) + (size_t)(u.pm * 4 + u.pn) * 65536; bf16* MG = (bf16*)(ws + WS_MERGED);
        const int row0 = u.pm * 256 + wr * 64 + fr, col0 = u.pn * 256 + 32 * wc + 4 * fq; const unsigned ll = llt_lane(wr, wc, fr, fq);
#pragma unroll
        for (int ai = 0; ai < 2; ++ai)
#pragma unroll
            for (int mp = 0; mp < 2; ++mp) {
                unsigned lo = ll; asm volatile("" : "+v"(lo));
                unsigned gv[2][2][2]; u32x2 pv[2][2][2];
#pragma unroll
                for (int mi = 0; mi < 2; ++mi)
#pragma unroll
                    for (int bj = 0; bj < 2; ++bj)
#pragma unroll
                        for (int nn = 0; nn < 2; ++nn) { const unsigned o = lo + llt_q(ai, bj, 2 * mp + mi, nn); gv[mi][bj][nn] = *(const unsigned*)(G + o); if (n > 0) pv[mi][bj][nn] = *(const u32x2*)(MP + o); else pv[mi][bj][nn] = (u32x2){0u, 0u}; }
#pragma unroll
                for (int mi = 0; mi < 2; ++mi) { const int m = 2 * mp + mi, row = row0 + ai * 128 + m * 16;
#pragma unroll
                    for (int bj = 0; bj < 2; ++bj)
#pragma unroll
                        for (int nn = 0; nn < 2; ++nn) { const int col = col0 + 128 * bj + 16 * nn; const unsigned o = lo + llt_q(ai, bj, m, nn);
                            const unsigned gw = gv[mi][bj][nn]; const u32x2 pw = pv[mi][bj][nn];
                            const f32x4 g = (f32x4){(float)(gw & 255u), (float)((gw >> 8) & 255u), (float)((gw >> 16) & 255u), (float)(gw >> 24)} * (1.0f / 255.0f);
                            const f32x4 pp = (f32x4){__builtin_bit_cast(float, pw.x << 16), __builtin_bit_cast(float, pw.x & 0xffff0000u), __builtin_bit_cast(float, pw.y << 16), __builtin_bit_cast(float, pw.y & 0xffff0000u)};
                            f32x4 v = acc[ai][bj][m][nn] * g + pp;
                            if (n < 3) st_bf16x4(MP + o, v); else st_bf16x4(MG + (size_t)row * DM + col, v); } }
                asm volatile("" ::: "memory"); }
    }
};
struct EpiResid {
    static constexpr bool PERM = false, AFTER_DRAIN = false;
    unsigned char* ws; float* xo; int dry; const float* xin;
    __device__ __forceinline__ void operator()(AccRef acc, const pg8::Unit& u, int wr, int wc, int fr, int fq) const {
        bf16* XB = (bf16*)(ws + WS_XB);
        const int row0 = u.pm * 256 + wr * 64 + fr, col0 = u.pn * 256 + 32 * wc + 4 * fq;
#pragma unroll
        for (int ai = 0; ai < 2; ++ai) {
            f32x4 xv[4][2][2];
#pragma unroll
            for (int m = 0; m < 4; ++m)
#pragma unroll
                for (int bj = 0; bj < 2; ++bj)
#pragma unroll
                    for (int nn = 0; nn < 2; ++nn) xv[m][bj][nn] = *(const f32x4*)(xin + (size_t)(row0 + ai * 128 + m * 16) * DM + col0 + 128 * bj + 16 * nn);
#pragma unroll
            for (int m = 0; m < 4; ++m)
#pragma unroll
                for (int bj = 0; bj < 2; ++bj)
#pragma unroll
                    for (int nn = 0; nn < 2; ++nn) { const size_t o = (size_t)(row0 + ai * 128 + m * 16) * DM + col0 + 128 * bj + 16 * nn; const f32x4 v = xv[m][bj][nn] + acc[ai][bj][m][nn];
                        if (!dry) { *(f32x4*)(xo + o) = v; st_bf16x4(XB + o, v); } else asm volatile("" :: "v"(v)); }
            asm volatile("" ::: "memory"); }
    }
};
struct EpiSwiglu {
    static constexpr bool PERM = false, AFTER_DRAIN = false;
    unsigned char* ws;
    __device__ __forceinline__ void operator()(AccRef acc, const pg8::Unit& u, int wr, int wc, int fr, int fq) const {
        const float* rsc = (const float*)(ws + WS_SEL); bf16* HB = (bf16*)(ws + WS_HB);
        const int row0 = u.pm * 256 + wr * 64 + fr, col0 = (u.pn & 7) * 128 + 32 * wc + 4 * fq;
#pragma unroll
        for (int ai = 0; ai < 2; ++ai)
#pragma unroll
            for (int m = 0; m < 4; ++m) { const int row = row0 + ai * 128 + m * 16; const float r = rsc[row];
#pragma unroll
                for (int nn = 0; nn < 2; ++nn) { const f32x4 g = acc[ai][0][m][nn] * r, up = acc[ai][1][m][nn] * r; f32x4 h;
#pragma unroll
                    for (int j = 0; j < 4; ++j) h[j] = g[j] * sigmoidf_(g[j]) * up[j];
                    st_bf16x4(HB + (size_t)row * DM + col0 + 16 * nn, h); } }
    }
};
struct EpiDown {
    static constexpr bool PERM = false, AFTER_DRAIN = false;
    unsigned char* ws;
    __device__ __forceinline__ void operator()(AccRef acc, const pg8::Unit& u, int wr, int wc, int fr, int fq) const {
        const float* aff = (const float*)(ws + WS_SEL) + NSLOT; bf16* YE = (bf16*)(ws + WS_XE);
        const int row0 = u.pm * 256 + wr * 64 + fr, col0 = (u.pn & 3) * 256 + 32 * wc + 4 * fq;
#pragma unroll
        for (int ai = 0; ai < 2; ++ai)
#pragma unroll
            for (int m = 0; m < 4; ++m) { const int row = row0 + ai * 128 + m * 16; const float r = 1.0f; (void)aff;
#pragma unroll
                for (int bj = 0; bj < 2; ++bj)
#pragma unroll
                    for (int nn = 0; nn < 2; ++nn) st_bf16x4(YE + (size_t)row * DM + col0 + 128 * bj + 16 * nn, acc[ai][bj][m][nn] * r); }
    }
};
struct EpiPP {
    static constexpr bool PERM = false, AFTER_DRAIN = false;
    unsigned char* ws;
    __device__ __forceinline__ void operator()(AccRef acc, const pg8::Unit& u, int wr, int wc, int fr, int fq) const {
        bf16* PPt = (bf16*)(ws + WS_PP) + (size_t)(u.pm * 4 + u.pn) * 65536; const unsigned ll = llt_lane(wr, wc, fr, fq);
#pragma unroll
        for (int ai = 0; ai < 2; ++ai)
#pragma unroll
            for (int m = 0; m < 4; ++m) { unsigned lo = ll; asm volatile("" : "+v"(lo));
#pragma unroll
                for (int bj = 0; bj < 2; ++bj)
#pragma unroll
                    for (int nn = 0; nn < 2; ++nn) st_bf16x4(PPt + (lo + llt_q(ai, bj, m, nn)), acc[ai][bj][m][nn]); }
    }
};
struct EpiPle {
    static constexpr bool PERM = false, AFTER_DRAIN = false;
    unsigned char* ws; float* xo; float* ssn; int dry;
    __device__ __forceinline__ void operator()(AccRef acc, const pg8::Unit& u, int wr, int wc, int fr, int fq) const {
        const float* ir3 = (const float*)(ws + WS_STAT) + (size_t)6 * TOK; const bf16* PPt = (const bf16*)(ws + WS_PP) + (size_t)(u.pm * 4 + u.pn) * 65536; bf16* XB = (bf16*)(ws + WS_XB); const unsigned ll = llt_lane(wr, wc, fr, fq);
        const int row0 = u.pm * 256 + wr * 64 + fr, col0 = u.pn * 256 + 32 * wc + 4 * fq;
#pragma unroll
        for (int ai = 0; ai < 2; ++ai)
#pragma unroll
            for (int mp = 0; mp < 2; ++mp) {
                unsigned lo = ll; asm volatile("" : "+v"(lo));
                f32x4 xv[2][2][2]; u32x2 pw[2][2][2]; float rr[2];
#pragma unroll
                for (int mi = 0; mi < 2; ++mi) { const int m = 2 * mp + mi, row = row0 + ai * 128 + m * 16; rr[mi] = ir3[row];
#pragma unroll
                    for (int bj = 0; bj < 2; ++bj)
#pragma unroll
                        for (int nn = 0; nn < 2; ++nn) { xv[mi][bj][nn] = *(const f32x4*)(xo + (size_t)row * DM + col0 + 128 * bj + 16 * nn); pw[mi][bj][nn] = *(const u32x2*)(PPt + (lo + llt_q(ai, bj, m, nn))); } }
#pragma unroll
                for (int mi = 0; mi < 2; ++mi) { const int m = 2 * mp + mi, row = row0 + ai * 128 + m * 16; float s = 0.f;
#pragma unroll
                    for (int bj = 0; bj < 2; ++bj)
#pragma unroll
                        for (int nn = 0; nn < 2; ++nn) { const size_t o = (size_t)row * DM + col0 + 128 * bj + 16 * nn; const f32x4 a = acc[ai][bj][m][nn] * rr[mi]; const u32x2 w = pw[mi][bj][nn];
                            const f32x4 pp = (f32x4){__builtin_bit_cast(float, w.x << 16), __builtin_bit_cast(float, w.x & 0xffff0000u), __builtin_bit_cast(float, w.y << 16), __builtin_bit_cast(float, w.y & 0xffff0000u)};
                            f32x4 v = xv[mi][bj][nn];
#pragma unroll
                            for (int j = 0; j < 4; ++j) v[j] += ((MK_DROP >> 5) & 1) ? 0.f : sigmoidf_(a[j]) * pp[j];
                            if (!dry) { *(f32x4*)(xo + o) = v; st_bf16x4(XB + o, v); } s += (v.x * v.x + v.y * v.y) + (v.z * v.z + v.w * v.w); }
                    s += shx(s, 16, fq * 16 + fr); s += shx(s, 32, fq * 16 + fr); if (fq == 0) ssn[(size_t)row * 16 + u.pn * 4 + wc] = s; }
                asm volatile("" ::: "memory"); }
    }
};
struct MoeOrder {
    int G, c, npn, total;
    __device__ __forceinline__ bool next(int i, pg8::Unit& u) const {
        if (G != 256) { const int L = i * G + c; if (L >= total) return false; const int upe = 8 * npn, e = L / upe, rem = L % upe; u.pm = e * 8 + rem / npn; u.pn = e * npn + rem % npn; u.aux = 0; return true; }
        const int x = c & 7, k = c >> 3; int e, b, pn;
        if (npn == 8) { if (i >= 4) return false; e = 4 * i + (x >> 1); b = 4 * (x & 1) + (k >> 3); pn = k & 7; }
        else { if (i >= 2) return false; e = 8 * i + x; b = k >> 2; pn = k & 3; }
        u.pm = e * 8 + b; u.pn = e * npn + pn; u.aux = 0; return true;
    }
    __device__ __forceinline__ void ptrs(const pg8::Gemm& g, const pg8::Unit& u, size_t tstep, const char*& a, const char*& b) const { a = (const char*)g.A + (size_t)u.pm * tstep; b = (const char*)g.Bt + (size_t)u.pn * tstep; }
    __device__ __forceinline__ void a_ready(const pg8::Unit&) const {}
    __device__ __forceinline__ void done(const pg8::Unit&) const {}
};
struct BranchOrder {
    pg8::StaticOrder so;
    __device__ __forceinline__ bool next(int i, pg8::Unit& u) const { if (!so.next(i >> 2, u)) return false; u.aux = i & 3; return true; }
    __device__ __forceinline__ void ptrs(const pg8::Gemm& g, const pg8::Unit& u, size_t tstep, const char*& a, const char*& b) const { a = (const char*)g.A + (size_t)u.aux * (8 * MiB) + (size_t)u.pm * tstep; b = (const char*)g.Bt + (size_t)u.aux * (DM * 256 * 2) + (size_t)u.pn * tstep; }
    __device__ __forceinline__ void a_ready(const pg8::Unit&) const {}
    __device__ __forceinline__ void done(const pg8::Unit&) const {}
};


__device__ __forceinline__ float hy_uc(const bf16* up, int l, float w0, float w1, float w2, float bb) {
    const float a = l > 0 ? bf2f(up[l - 1]) : 0.f, b = bf2f(up[l]), c = l < SEQ - 1 ? bf2f(up[l + 1]) : 0.f;
    return w0 * a + w1 * b + w2 * c + bb;
}
__device__ __forceinline__ void hyena_phase(const Args& A, Frame& F, int li) {
    unsigned char* wsl = A.ws; asm volatile("" : "+s"(wsl));
    LAS f32x2* bufA = (LAS f32x2*)(F.lds + FFT_BUF_OFF); LAS f32x2* bufB = (LAS f32x2*)(F.lds + FFT_BUF1_OFF); const LAS f32x2* tw = (const LAS f32x2*)(F.lds + FFT_TW_OFF); LAS bf16* stg = (LAS bf16*)(F.lds + FFT_STAGE_OFF);
    const bf16* U = (const bf16*)(wsl + WS_UHYT); const f32x2* KF = (const f32x2*)(wsl + WS_KF); bf16* Y = (bf16*)(wsl + WS_YHY);
    const float* cw = A.in[5] + li * 3 * 768; const float* cb = A.in[6] + li * 768; const float* skip = A.in[13] + li * 512;
    const int tid = F.tid; float zf = 0.f; asm volatile("" : "+v"(zf));
    for (int unit = blockIdx.x; unit < 256; unit += F.G) {
        const int bp = unit >> 6, c0 = (unit & 63) * 4, b0 = 2 * bp;
        for (int cp = 0; cp < 2; ++cp) {
            float v[2][2][4], x1[2][2][4], x2[2][2][4], z[2][2][4];
#pragma unroll
            for (int q = 0; q < 2; ++q) { const int c = c0 + 2 * cp + q;
                const float a0 = cw[c], a1 = cw[768 + c], a2 = cw[1536 + c], ab = cb[c];
                const float d0 = cw[256 + c], d1 = cw[768 + 256 + c], d2 = cw[1536 + 256 + c], db = cb[256 + c];
                const float e0 = cw[512 + c], e1 = cw[768 + 512 + c], e2 = cw[1536 + 512 + c], eb = cb[512 + c];
#pragma unroll
                for (int bb = 0; bb < 2; ++bb) { const bf16* ub = U + (size_t)((b0 + bb) * 768) * SEQ;
#pragma unroll
                    for (int k = 0; k < 4; ++k) { const int l = tid + 512 * k;
                        x1[q][bb][k] = hy_uc(ub + (size_t)c * SEQ, l, a0, a1, a2, ab);
                        x2[q][bb][k] = hy_uc(ub + (size_t)(256 + c) * SEQ, l, d0, d1, d2, db);
                        v[q][bb][k] = hy_uc(ub + (size_t)(512 + c) * SEQ, l, e0, e1, e2, eb); }
                    asm volatile("" ::: "memory"); } }
#pragma unroll
            for (int k = 0; k < 4; ++k) { const int l = tid + 512 * k;
                bufA[fpad(l)] = (f32x2){v[0][0][k], v[0][1][k]}; bufA[fpad(2048 + l)] = (f32x2){zf, zf};
                bufB[fpad(l)] = (f32x2){v[1][0][k], v[1][1][k]}; bufB[fpad(2048 + l)] = (f32x2){zf, zf}; }
            __syncthreads();
#pragma unroll 1
            for (int o = 0; o < 2; ++o) {
                const f32x2* kfa = KF + (size_t)(o * 256 + c0 + 2 * cp) * 4096; f32x2 ka[8], kb[8];
                fft_stage_fwd<0>(bufA, tw, tid); fft_stage_fwd<0>(bufB, tw, tid); __syncthreads();
                fft_stage_fwd<1>(bufA, tw, tid); fft_stage_fwd<1>(bufB, tw, tid); __syncthreads();
                fft_stage_fwd<2>(bufA, tw, tid); fft_stage_fwd<2>(bufB, tw, tid); __syncthreads();
#pragma unroll
                for (int k = 0; k < 8; ++k) { ka[k] = kfa[tid + 512 * k]; kb[k] = kfa[4096 + tid + 512 * k]; }
                fft_stage_fwd<3>(bufA, tw, tid); fft_stage_fwd<3>(bufB, tw, tid); __syncthreads();
#pragma unroll
                for (int k = 0; k < 8; ++k) { const int p = fpad(tid + 512 * k); bufA[p] = cmul(bufA[p], ka[k]); bufB[p] = cmul(bufB[p], kb[k]); }
                __syncthreads();
                fft_inv2(bufA, bufB, tw, tid);
                const float sa = skip[o * 256 + c0 + 2 * cp], sb = skip[o * 256 + c0 + 2 * cp + 1];
                if (o == 0) {
#pragma unroll
                    for (int k = 0; k < 4; ++k) { const int l = tid + 512 * k; const f32x2 ya = bufA[fpad(l)], yb = bufB[fpad(l)];
                        z[0][0][k] = x1[0][0][k] * (ya.x + v[0][0][k] * sa); z[0][1][k] = x1[0][1][k] * (ya.y + v[0][1][k] * sa);
                        z[1][0][k] = x1[1][0][k] * (yb.x + v[1][0][k] * sb); z[1][1][k] = x1[1][1][k] * (yb.y + v[1][1][k] * sb);
                        bufA[fpad(l)] = (f32x2){z[0][0][k], z[0][1][k]}; bufA[fpad(2048 + l)] = (f32x2){zf, zf};
                        bufB[fpad(l)] = (f32x2){z[1][0][k], z[1][1][k]}; bufB[fpad(2048 + l)] = (f32x2){zf, zf}; }
                } else {
#pragma unroll
                    for (int k = 0; k < 4; ++k) { const int l = tid + 512 * k; const f32x2 ya = bufA[fpad(l)], yb = bufB[fpad(l)];
                        const unsigned wa = cvtpk(x2[0][0][k] * (ya.x + z[0][0][k] * sa), x2[0][1][k] * (ya.y + z[0][1][k] * sa));
                        const unsigned wb = cvtpk(x2[1][0][k] * (yb.x + z[1][0][k] * sb), x2[1][1][k] * (yb.y + z[1][1][k] * sb));
                        *(LAS unsigned*)(stg + (size_t)l * 4 + 2 * cp) = (wa & 0xffffu) | (wb << 16);
                        *(LAS unsigned*)(stg + (size_t)(2048 + l) * 4 + 2 * cp) = (wa >> 16) | (wb & 0xffff0000u); }
                }
                __syncthreads();
            }
        }
        int tq = tid; asm volatile("" : "+v"(tq));
#pragma unroll 2
        for (int k = 0; k < 8; ++k) { const int t = tq + 512 * k, bb = t >> 11, l = t & 2047;
            *(u32x2*)(Y + (size_t)((b0 + bb) * SEQ + l) * 256 + c0) = *(const LAS u32x2*)(stg + (size_t)t * 4); }
        __syncthreads();
    }
}
__device__ __forceinline__ void fnet_phase(const Args& A, Frame& F) {
    unsigned char* wsl = A.ws; asm volatile("" : "+s"(wsl));
    LAS f32x2* bufA = (LAS f32x2*)(F.lds + FFT_BUF_OFF); LAS f32x2* bufB = (LAS f32x2*)(F.lds + FFT_BUF1_OFF); const LAS f32x2* tw = (const LAS f32x2*)(F.lds + FFT_TW_OFF); LAS bf16* stg = (LAS bf16*)(F.lds + FFT_STAGE_OFF);
    const bf16* U = (const bf16*)(wsl + WS_UFNT); bf16* Y = (bf16*)(wsl + WS_YFN);
    const int tid = F.tid; float zf = 0.f; asm volatile("" : "+v"(zf));
    for (int unit = blockIdx.x; unit < 256; unit += F.G) {
        const int b = unit >> 5, g = (unit >> 3) & 3, ch = unit & 7;
        for (int fp = 0; fp < 2; ++fp) {
            const int mA = 4 * ch + 2 * fp, mB = mA + 1;
            const bf16* ub = U + (size_t)(b * 256 + 64 * g) * SEQ;
#pragma unroll
            for (int k = 0; k < 4; ++k) { const int l = tid + 512 * k;
                bufA[fpad(l)] = (f32x2){bf2f(ub[(size_t)mA * SEQ + l]), bf2f(ub[(size_t)(32 + mA) * SEQ + l])}; bufA[fpad(2048 + l)] = (f32x2){zf, zf};
                bufB[fpad(l)] = (f32x2){bf2f(ub[(size_t)mB * SEQ + l]), bf2f(ub[(size_t)(32 + mB) * SEQ + l])}; bufB[fpad(2048 + l)] = (f32x2){zf, zf}; }
            __syncthreads();
            fft_fwd2(bufA, bufB, tw, tid);
#pragma unroll
            for (int k = 0; k < 4; ++k) { const int kk = tid + 512 * k; const int p1 = fpad(digrev(2 * kk)), p2 = fpad(digrev((2 * (2048 - kk)) & 4095));
                const f32x2 a1 = bufA[p1], a2 = bufA[p2], b1 = bufB[p1], b2 = bufB[p2];
                float ya, yb;
                if (mA == 0) { ya = 0.5f * (a1.x + a2.x); yb = 0.5f * (a1.y + a2.y); } else { ya = a1.x; yb = a2.x; }
                const unsigned w1 = cvtpk(ya, b1.x), w2 = cvtpk(b2.x, yb);
                *(LAS unsigned*)(stg + (size_t)kk * 8 + 2 * fp) = w1;
                *(LAS unsigned*)(stg + (size_t)kk * 8 + 6 - 2 * fp) = w2; }
            __syncthreads();
        }
#pragma unroll
        for (int k = 0; k < 4; ++k) { const int kk = tid + 512 * k; const v4u w = *(const LAS v4u*)(stg + (size_t)kk * 8);
            bf16* yr = Y + (size_t)(b * SEQ + kk) * 256 + 64 * g;
            *(u32x2*)(yr + 4 * ch) = (u32x2){w.x, w.y};
            bf16* y2 = yr + 61 - 4 * ch;
            y2[0] = (bf16)w.z; y2[1] = (bf16)(w.z >> 16); y2[2] = (bf16)w.w;
            if (ch == 0) yr[32] = (bf16)(w.w >> 16); else y2[3] = (bf16)(w.w >> 16); }
        __syncthreads();
    }
}
__device__ __forceinline__ void softmax_step(f32x16 (&S)[2], float& mrun, float& lrun, f32x16& o0, f32x16& o1, bf16x8 (&pf)[2][2], int lane) {
    float mx = S[0][0];
#pragma unroll
    for (int kb = 0; kb < 2; ++kb)
#pragma unroll
        for (int r = 0; r < 16; ++r) mx = fmaxf(mx, S[kb][r]);
    mx = fmaxf(mx, shx(mx, 32, lane));
    if (__any(mx > mrun + 8.0f)) { const float mnew = fmaxf(mrun, mx), alpha = fast_exp2(mrun - mnew); mrun = mnew; lrun *= alpha; o0 *= alpha; o1 *= alpha; }
    float ls = 0.f;
#pragma unroll
    for (int kb = 0; kb < 2; ++kb)
#pragma unroll
        for (int r = 0; r < 16; ++r) { const float p = fast_exp2(S[kb][r] - mrun); S[kb][r] = p; ls += p; }
    lrun += ls;
#pragma unroll
    for (int kb = 0; kb < 2; ++kb)
#pragma unroll
        for (int s2 = 0; s2 < 2; ++s2) { v4u w; w.x = cvtpk(S[kb][8 * s2 + 0], S[kb][8 * s2 + 1]); w.y = cvtpk(S[kb][8 * s2 + 2], S[kb][8 * s2 + 3]);
            w.z = cvtpk(S[kb][8 * s2 + 4], S[kb][8 * s2 + 5]); w.w = cvtpk(S[kb][8 * s2 + 6], S[kb][8 * s2 + 7]); pf[kb][s2] = __builtin_bit_cast(bf16x8, w); }
}
__device__ __forceinline__ void attn_store(bf16* yrow, const f32x16& o0, const f32x16& o1, float lrun, int hh, int lane) {
    const float lt = lrun + shx(lrun, 32, lane), inv = 1.0f / lt;
#pragma unroll
    for (int g = 0; g < 4; ++g) {
        st_bf16x4(yrow + 8 * g + 4 * hh, (f32x4){o0[4 * g] * inv, o0[4 * g + 1] * inv, o0[4 * g + 2] * inv, o0[4 * g + 3] * inv});
        st_bf16x4(yrow + 32 + 8 * g + 4 * hh, (f32x4){o1[4 * g] * inv, o1[4 * g + 1] * inv, o1[4 * g + 2] * inv, o1[4 * g + 3] * inv}); }
}
constexpr int NA_KP = 144, NA_VP = 136, NA_KB = 64 * NA_KP, NA_VB = 64 * NA_VP, NA_BUF = NA_KB + NA_VB, NA_RPB_OFF = 2 * NA_BUF;
__device__ __forceinline__ void na_phase(const Args& A, Frame& F, int li) {
    unsigned char* wsl = A.ws; asm volatile("" : "+s"(wsl));
    LAS float* rpbL = (LAS float*)(F.lds + NA_RPB_OFF);
    const float* rpb = A.in[18] + li * 4 * 15 * 31;
    for (int i = F.tid; i < 60 * 128; i += NTHR) { const int rw = i >> 7, dc = (i & 127) - 48; rpbL[i] = (dc >= 0 && dc < 31) ? rpb[rw * 31 + dc] * LOG2E : 0.f; }
    __syncthreads();
    const bf16* NQ = (const bf16*)(wsl + WS_NAQ); const bf16* NK = (const bf16*)(wsl + WS_NAK); const bf16* NVT = (const bf16*)(wsl + WS_NAVT); bf16* Y = (bf16*)(wsl + WS_YNA);
    const int tid = F.tid, lane = F.lane, hh = lane >> 5, lq = lane & 31;
    for (int unit = F.vcu; unit < 256; unit += F.G) {
        const int b = unit >> 5, h = (unit >> 3) & 3, r0 = (unit & 7) * 4;
        const int r = r0 + (F.wave >> 1), half = F.wave & 1;
        const int qtok = b * SEQ + r * 64 + half * 32 + lq, c = half * 32 + lq, cs = min(max(c - 8, 0), 48), rs = min(max(r - 4, 0), 24);
        const int klo = min(max(r0 - 4, 0), 24), khi = min(max(r0 + 3 - 4, 0), 24) + 7, nrow = khi - klo + 1;
        bf16x8 qf[4];
#pragma unroll
        for (int ks = 0; ks < 4; ++ks) qf[ks] = *(const bf16x8*)(NQ + (size_t)qtok * 256 + h * 64 + 16 * ks + 8 * hh);
        const bf16* Kg = NK + (size_t)(b * SEQ) * 256 + h * 64; const bf16* Vg = NVT + (size_t)(b * 256 + h * 64) * SEQ;
        const int kk = tid >> 3, kch = tid & 7;
        v4u rk, rv;
#define NA_LOAD(krow) do { rk = *(const v4u*)(Kg + (size_t)((krow) * 64 + kk) * 256 + kch * 8); rv = *(const v4u*)(Vg + (size_t)kk * SEQ + (krow) * 64 + kch * 8); } while (0)
#define NA_WRITE(bufi) do { LAS unsigned char* kb_ = F.lds + (bufi) * NA_BUF; *(LAS v4u*)(kb_ + kk * NA_KP + kch * 16) = rk; \
        LAS unsigned char* vb_ = kb_ + NA_KB + kk * NA_VP + kch * 16; *(LAS u32x2*)vb_ = (u32x2){rv.x, rv.y}; *(LAS u32x2*)(vb_ + 8) = (u32x2){rv.z, rv.w}; } while (0)
        f32x16 o0, o1;
#pragma unroll
        for (int i = 0; i < 16; ++i) { o0[i] = 0.f; o1[i] = 0.f; }
        float mrun = -1e30f, lrun = 0.f;
        NA_LOAD(klo); NA_WRITE(0);
        __syncthreads();
        for (int t = 0; t < nrow; ++t) {
            const int krow = klo + t;
            if (t + 1 < nrow) NA_LOAD(krow + 1);
            if (krow >= rs && krow < rs + 8) {
                const LAS unsigned char* kbuf = F.lds + (t & 1) * NA_BUF; const LAS unsigned char* vbuf = kbuf + NA_KB;
                const LAS float* bp = rpbL + (h * 15 + (krow - r + 7)) * 128 + (4 * hh - c + 15 + 48);
                f32x16 S[2];
#pragma unroll
                for (int kb = 0; kb < 2; ++kb) { f32x16 s;
#pragma unroll
                    for (int i = 0; i < 16; ++i) s[i] = 0.f;
#pragma unroll
                    for (int ks = 0; ks < 4; ++ks) s = __builtin_amdgcn_mfma_f32_32x32x16_bf16(*(const LAS bf16x8*)(kbuf + (kb * 32 + lq) * NA_KP + (16 * ks + 8 * hh) * 2), qf[ks], s, 0, 0, 0);
#pragma unroll
                    for (int rr = 0; rr < 16; ++rr) { const int ko = kb * 32 + (rr & 3) + 8 * (rr >> 2); const int kc = ko + 4 * hh; const bool ok = (kc >= cs) && (kc < cs + 16);
                        s[rr] = ok ? s[rr] + bp[ko] : -1e30f; }
                    S[kb] = s; }
                bf16x8 pf[2][2];
                softmax_step(S, mrun, lrun, o0, o1, pf, lane);
#pragma unroll
                for (int kb = 0; kb < 2; ++kb)
#pragma unroll
                    for (int s2 = 0; s2 < 2; ++s2) {
#pragma unroll
                        for (int db = 0; db < 2; ++db) { const LAS unsigned char* vp = vbuf + (db * 32 + lq) * NA_VP + (kb * 32 + 16 * s2 + 4 * hh) * 2;
                            const u32x2 lo = *(const LAS u32x2*)vp, hi = *(const LAS u32x2*)(vp + 16); const bf16x8 va = __builtin_bit_cast(bf16x8, (v4u){lo.x, lo.y, hi.x, hi.y});
                            if (db == 0) o0 = __builtin_amdgcn_mfma_f32_32x32x16_bf16(va, pf[kb][s2], o0, 0, 0, 0); else o1 = __builtin_amdgcn_mfma_f32_32x32x16_bf16(va, pf[kb][s2], o1, 0, 0, 0); } }
            }
            if (t + 1 < nrow) NA_WRITE((t + 1) & 1);
            __syncthreads();
        }
#undef NA_LOAD
#undef NA_WRITE
        attn_store(Y + (size_t)qtok * 256 + h * 64, o0, o1, lrun, hh, lane);
    }
}
constexpr int AT_KP = 208, AT_VP = 136, AT_KB = 64 * AT_KP, AT_VB = 64 * AT_VP, AT_BUF = AT_KB + AT_VB;
__device__ __forceinline__ void mla_attn_phase(const Args& A, Frame& F) {
    unsigned char* wsl = A.ws; asm volatile("" : "+s"(wsl));
    const bf16* Q = (const bf16*)(wsl + WS_Q); const bf16* KFU = (const bf16*)(wsl + WS_KFULL); const bf16* VT = (const bf16*)(wsl + WS_VT); bf16* Y = (bf16*)(wsl + WS_YMLA);
    const int tid = F.tid, lane = F.lane, hh = lane >> 5, lq = lane & 31;
    for (int unit = F.vcu; unit < 256; unit += F.G) {
        const int b = unit >> 5, h = (unit >> 3) & 3, qb = unit & 7;
        const int qtok = b * SEQ + qb * 256 + F.wave * 32 + lq;
        bf16x8 qf[6];
#pragma unroll
        for (int ks = 0; ks < 6; ++ks) qf[ks] = *(const bf16x8*)(Q + (size_t)qtok * 384 + h * 96 + 16 * ks + 8 * hh);
        const bf16* Kg = KFU + (size_t)(b * SEQ) * 384 + h * 96; const bf16* Vg = VT + (size_t)((b * 4 + h) * 64) * SEQ;
        const int kc0 = tid, kc1 = tid + 512; const bool k1ok = kc1 < 768;
        const int kk0 = kc0 / 12, kch0 = kc0 % 12, kk1 = k1ok ? kc1 / 12 : 0, kch1 = k1ok ? kc1 % 12 : 0, vd = tid >> 3, vch = tid & 7;
        v4u rk0, rk1, rv;
#define AT_LOAD(t) do { const int key0 = (t) * 64; rk0 = *(const v4u*)(Kg + (size_t)(key0 + kk0) * 384 + kch0 * 8); if (k1ok) rk1 = *(const v4u*)(Kg + (size_t)(key0 + kk1) * 384 + kch1 * 8); \
        rv = *(const v4u*)(Vg + (size_t)vd * SEQ + key0 + vch * 8); } while (0)
#define AT_WRITE(bufi) do { LAS unsigned char* kb_ = F.lds + (bufi) * AT_BUF; *(LAS v4u*)(kb_ + kk0 * AT_KP + kch0 * 16) = rk0; if (k1ok) *(LAS v4u*)(kb_ + kk1 * AT_KP + kch1 * 16) = rk1; \
        LAS unsigned char* vb_ = kb_ + AT_KB + vd * AT_VP + vch * 16; *(LAS u32x2*)vb_ = (u32x2){rv.x, rv.y}; *(LAS u32x2*)(vb_ + 8) = (u32x2){rv.z, rv.w}; } while (0)
        f32x16 o0, o1;
#pragma unroll
        for (int i = 0; i < 16; ++i) { o0[i] = 0.f; o1[i] = 0.f; }
        float mrun = -1e30f, lrun = 0.f;
        AT_LOAD(0); AT_WRITE(0);
        __syncthreads();
        for (int t = 0; t < 32; ++t) {
            if (t + 1 < 32) AT_LOAD(t + 1);
            const LAS unsigned char* kbuf = F.lds + (t & 1) * AT_BUF; const LAS unsigned char* vbuf = kbuf + AT_KB;
            f32x16 S[2];
            __builtin_amdgcn_s_setprio(1);
#pragma unroll
            for (int kb = 0; kb < 2; ++kb) { f32x16 s;
#pragma unroll
                for (int i = 0; i < 16; ++i) s[i] = 0.f;
#pragma unroll
                for (int ks = 0; ks < 6; ++ks) s = __builtin_amdgcn_mfma_f32_32x32x16_bf16(*(const LAS bf16x8*)(kbuf + (kb * 32 + lq) * AT_KP + (16 * ks + 8 * hh) * 2), qf[ks], s, 0, 0, 0);
                S[kb] = s; }
            __builtin_amdgcn_s_setprio(0);
            bf16x8 pf[2][2];
            softmax_step(S, mrun, lrun, o0, o1, pf, lane);
            __builtin_amdgcn_s_setprio(1);
#pragma unroll
            for (int kb = 0; kb < 2; ++kb)
#pragma unroll
                for (int s2 = 0; s2 < 2; ++s2) {
#pragma unroll
                    for (int db = 0; db < 2; ++db) { const LAS unsigned char* vp = vbuf + (db * 32 + lq) * AT_VP + (kb * 32 + 16 * s2 + 4 * hh) * 2;
                        const u32x2 lo = *(const LAS u32x2*)vp, hi = *(const LAS u32x2*)(vp + 16); const bf16x8 va = __builtin_bit_cast(bf16x8, (v4u){lo.x, lo.y, hi.x, hi.y});
                        if (db == 0) o0 = __builtin_amdgcn_mfma_f32_32x32x16_bf16(va, pf[kb][s2], o0, 0, 0, 0); else o1 = __builtin_amdgcn_mfma_f32_32x32x16_bf16(va, pf[kb][s2], o1, 0, 0, 0); } }
            __builtin_amdgcn_s_setprio(0);
            if (t + 1 < 32) AT_WRITE((t + 1) & 1);
            __syncthreads();
        }
#undef AT_LOAD
#undef AT_WRITE
        attn_store(Y + (size_t)qtok * 256 + h * 64, o0, o1, lrun, hh, lane);
    }
}
#ifndef MK_DEBUG
#define MK_DEBUG 0
#endif

__device__ __forceinline__ void router_phase(const Args& A, Frame& F, int li) {
    unsigned char* wsl = A.ws; asm volatile("" : "+s"(wsl));
    LAS float* wL = (LAS float*)F.lds;
    const float* wr = A.in[22] + (size_t)li * DM * NEXP; const float* g2 = A.in[21] + li * DM;
    for (int i = F.tid; i < DM * NEXP; i += NTHR) { const int k = i >> 4, e = i & 15; wL[(k >> 2) * 64 + e * 4 + (k & 3)] = wr[i] * g2[k]; }
    __syncthreads();
    float* AFF = (float*)(wsl + WS_AFF); float* IR2 = (float*)(wsl + WS_STAT) + (size_t)5 * TOK;
    const int gw = F.vcu * NWAVES + F.wave, NGW = F.G * NWAVES, lane = F.lane, g = lane >> 4, j = lane & 15;
    for (int grp = gw; grp < TOK / 16; grp += NGW) {
        const int row0 = grp * 16;
        const float* xp = A.out + (size_t)(row0 + j) * DM + 4 * g; const LAS float* wp = wL + g * 64 + 4 * j;
        f32x4 acc = (f32x4){0.f, 0.f, 0.f, 0.f}; float ss = 0.f;
#pragma unroll 8
        for (int t = 0; t < 64; ++t) { const f32x4 xv = *(const f32x4*)(xp + 16 * t); const f32x4 wv = *(const LAS f32x4*)(wp + 256 * t);
            ss += (xv.x * xv.x + xv.y * xv.y) + (xv.z * xv.z + xv.w * xv.w);
            acc = __builtin_amdgcn_mfma_f32_16x16x4f32(xv.x, wv.x, acc, 0, 0, 0); acc = __builtin_amdgcn_mfma_f32_16x16x4f32(xv.y, wv.y, acc, 0, 0, 0);
            acc = __builtin_amdgcn_mfma_f32_16x16x4f32(xv.z, wv.z, acc, 0, 0, 0); acc = __builtin_amdgcn_mfma_f32_16x16x4f32(xv.w, wv.w, acc, 0, 0, 0); }
        ss += shx(ss, 16, lane); ss += shx(ss, 32, lane);
        const float inv = rsqrtf(ss * (1.0f / 1024.0f) + EPS);
        const int b = row0 >> 11, l0 = row0 & 2047;
#pragma unroll
        for (int r = 0; r < 4; ++r) {
            const float lg = acc[r] * shl_from(inv, 4 * g + r);
            float mx = lg;
#pragma unroll
            for (int o = 1; o < 16; o <<= 1) mx = fmaxf(mx, shx(mx, o, lane));
            const float ex = __expf(lg - mx); float den = ex;
#pragma unroll
            for (int o = 1; o < 16; o <<= 1) den += shx(den, o, lane);
            AFF[(size_t)(b * NEXP + j) * SEQ + l0 + 4 * g + r] = ex / den;
        }
        if (g == 0) IR2[row0 + j] = inv;
    }
}
__device__ __forceinline__ void topk_phase(const Args& A, Frame& F) {
    unsigned char* wsl = A.ws; asm volatile("" : "+s"(wsl));
    LAS unsigned* hist = (LAS unsigned*)F.lds;
    LAS unsigned* sh = hist + 256;
    LAS int* idxL = (LAS int*)(hist + 512);
    const float* AFF = (const float*)(wsl + WS_AFF); const float* IR2 = (const float*)(wsl + WS_STAT) + (size_t)5 * TOK;
    int* INV = (int*)(wsl + WS_INV); float* ROWSC = (float*)(wsl + WS_SEL); float* SELAFF = ROWSC + NSLOT;
    const bf16* XB = (const bf16*)(wsl + WS_XB); bf16* XE = (bf16*)(wsl + WS_XE);
    const int tid = F.tid, lane = F.lane, wave = F.wave;
    for (int unit = blockIdx.x; unit < NB * NEXP; unit += F.G) {
        const int b = unit >> 4, e = unit & 15;
        const f32x4 av = *(const f32x4*)(AFF + (size_t)unit * SEQ + 4 * tid);
        unsigned key[4] = {__float_as_uint(av[0]), __float_as_uint(av[1]), __float_as_uint(av[2]), __float_as_uint(av[3])};
        unsigned prefix = 0u, krem = CAP;
        for (int pass = 0; pass < 4; ++pass) {
            const int shift = 24 - 8 * pass;
            if (tid < 256) hist[tid] = 0u;
            __syncthreads();
#pragma unroll
            for (int i = 0; i < 4; ++i) { const bool match = (pass == 0) || ((key[i] >> (shift + 8)) == (prefix >> (shift + 8))); if (match) __hip_atomic_fetch_add(&hist[(key[i] >> shift) & 255u], 1u, __ATOMIC_RELAXED, __HIP_MEMORY_SCOPE_WORKGROUP); }
            __syncthreads();
            if (wave == 0) {
                const unsigned c0 = hist[4 * lane], c1 = hist[4 * lane + 1], c2 = hist[4 * lane + 2], c3 = hist[4 * lane + 3], t = c0 + c1 + c2 + c3;
                unsigned v = t;
#pragma unroll
                for (int o = 1; o < 64; o <<= 1) { const unsigned uu = shlu_from(v, (lane + o) & 63); if (lane + o < 64) v += uu; }
                unsigned cum = v - t;
                if (cum < krem && cum + t >= krem) {
                    int bsel; unsigned knew;
                    if (cum + c3 >= krem) { bsel = 4 * lane + 3; knew = krem - cum; }
                    else if (cum + c3 + c2 >= krem) { bsel = 4 * lane + 2; knew = krem - cum - c3; }
                    else if (cum + c3 + c2 + c1 >= krem) { bsel = 4 * lane + 1; knew = krem - cum - c3 - c2; }
                    else { bsel = 4 * lane; knew = krem - cum - c3 - c2 - c1; }
                    sh[0] = prefix | ((unsigned)bsel << shift); sh[1] = knew; } }
            __syncthreads();
            prefix = sh[0]; krem = sh[1];
            __syncthreads();
        }
        unsigned eqc = 0u, gtc = 0u;
#pragma unroll
        for (int i = 0; i < 4; ++i) { eqc += key[i] == prefix; gtc += key[i] > prefix; }
        unsigned eqs = eqc;
#pragma unroll
        for (int o = 1; o < 64; o <<= 1) { const unsigned t = shlu_from(eqs, (lane - o) & 63); if (lane >= o) eqs += t; }
        if (lane == 63) sh[16 + wave] = eqs;
        __syncthreads();
        unsigned eqbase = eqs - eqc;
        for (int w = 0; w < wave; ++w) eqbase += sh[16 + w];
        __syncthreads();
        bool sel[4]; unsigned selc = 0u, er = eqbase;
#pragma unroll
        for (int i = 0; i < 4; ++i) { if (key[i] > prefix) sel[i] = true; else if (key[i] == prefix) { sel[i] = er < krem; ++er; } else sel[i] = false; selc += sel[i]; }
        unsigned ss = selc;
#pragma unroll
        for (int o = 1; o < 64; o <<= 1) { const unsigned t = shlu_from(ss, (lane - o) & 63); if (lane >= o) ss += t; }
        if (lane == 63) sh[32 + wave] = ss;
        __syncthreads();
        unsigned slot = ss - selc;
        for (int w = 0; w < wave; ++w) slot += sh[32 + w];
        const int grp = e * NB + b;
#pragma unroll
        for (int i = 0; i < 4; ++i) { const int l = 4 * tid + i; int sv = -1;
            if (sel[i]) { sv = (int)slot; ++slot; idxL[sv] = l; ROWSC[grp * CAP + sv] = IR2[b * SEQ + l]; SELAFF[grp * CAP + sv] = __builtin_bit_cast(float, key[i]); }
            INV[(size_t)(b * SEQ + l) * NEXP + e] = sv; }
        __syncthreads();
        for (int it = 0; it < 64; it += 4) {
            v4u r[4];
#pragma unroll
            for (int q = 0; q < 4; ++q) { const int srow = (it + q) * 4 + (tid >> 7); r[q] = *(const v4u*)(XB + (size_t)(b * SEQ + idxL[srow]) * DM + (tid & 127) * 8); }
#pragma unroll
            for (int q = 0; q < 4; ++q) { const int srow = (it + q) * 4 + (tid >> 7); *(v4u*)(XE + (size_t)(grp * CAP + srow) * DM + (tid & 127) * 8) = r[q]; }
        }
        __syncthreads();
    }
}

#if MK_DEBUG
__device__ __forceinline__ void debug_moe_check(const Args& A, Frame& F, int li) {
    unsigned char* wsl = A.ws; asm volatile("" : "+s"(wsl));
    LAS float* hs = (LAS float*)F.lds; LAS float* hid = hs + 1024; LAS float* red = hid + 1024; LAS int* tokp = (LAS int*)(red + 64);
    const int* INV = (const int*)(wsl + WS_INV); const bf16* YE = (const bf16*)(wsl + WS_XE); const float* AFF = (const float*)(wsl + WS_AFF);
    const float* g2 = A.in[21] + li * DM; const float* wg = A.in[23] + (size_t)li * NEXP * DM * DM; const float* wu = A.in[24] + (size_t)li * NEXP * DM * DM; const float* wd = A.in[25] + (size_t)li * NEXP * DM * DM;
    float* dbg = (float*)(wsl + WS_CTL) + 1024;
    const int tid = F.tid;
    for (int unit = blockIdx.x; unit < 256; unit += F.G) {
        const int grp = unit >> 1, slot = (unit & 1) * 131 + 7, e = grp >> 3, b = grp & 7;
        if (tid == 0) tokp[0] = -1;
        __syncthreads();
        for (int l = tid; l < SEQ; l += NTHR) if (INV[(size_t)(b * SEQ + l) * NEXP + e] == slot) tokp[0] = l;
        __syncthreads();
        const int l = tokp[0]; if (l < 0) { if (tid == 0) atomicAdd(dbg + 2, 1.0f); __syncthreads(); continue; }
        const float* xr = A.out + (size_t)(b * SEQ + l) * DM;
        float s = 0.f; for (int k = tid; k < DM; k += NTHR) s += xr[k] * xr[k];
        s = wave_sum(s, F.lane); if (F.lane == 0) red[F.wave] = s; __syncthreads();
        float tot = 0.f; for (int w = 0; w < 8; ++w) tot += red[w];
        const float inv = rsqrtf(tot * (1.0f / 1024.0f) + EPS);
        for (int k = tid; k < DM; k += NTHR) hs[k] = xr[k] * inv * g2[k];
        __syncthreads();
        for (int f = tid; f < DM; f += NTHR) { float g = 0.f, u = 0.f; for (int k = 0; k < DM; ++k) { g += hs[k] * wg[((size_t)e * DM + k) * DM + f]; u += hs[k] * wu[((size_t)e * DM + k) * DM + f]; }
            hid[f] = g / (1.0f + __expf(-g)) * u; }
        __syncthreads();
        { const bf16* XE_ = (const bf16*)(wsl + WS_XE); const bf16* XB_ = (const bf16*)(wsl + WS_XB); float mm = 0.f;
          for (int k = tid; k < DM; k += NTHR) mm += (XE_[(size_t)(grp * CAP + slot) * DM + k] != XB_[(size_t)(b * SEQ + l) * DM + k]) ? 1.f : 0.f;
          mm = wave_sum(mm, F.lane); if (F.lane == 0 && mm > 0.f) atomicAdd(dbg + 3, mm);
          const bf16* HB_ = (const bf16*)(wsl + WS_HB); float he = 0.f, hr = 0.f;
          for (int f = tid; f < DM; f += NTHR) { const float m2 = bf2f(HB_[(size_t)(grp * CAP + slot) * DM + f]); he += (hid[f] - m2) * (hid[f] - m2); hr += hid[f] * hid[f]; }
          he = wave_sum(he, F.lane); hr = wave_sum(hr, F.lane); if (F.lane == 0) { atomicAdd(dbg + 4, he); atomicAdd(dbg + 5, hr); } }
        { const float* wr = A.in[22] + (size_t)li * DM * NEXP;
          if (tid < 16) { float a = 0.f; for (int k = 0; k < DM; ++k) a += hs[k] * wr[k * NEXP + tid]; red[16 + tid] = a; }
          __syncthreads();
          if (tid == 0) { float mx = red[16]; for (int q = 1; q < 16; ++q) mx = fmaxf(mx, red[16 + q]); float den = 0.f; for (int q = 0; q < 16; ++q) den += __expf(red[16 + q] - mx);
              float ee = 0.f, rr = 0.f; for (int q = 0; q < 16; ++q) { const float t = __expf(red[16 + q] - mx) / den, m2 = AFF[(size_t)(b * NEXP + q) * SEQ + l]; ee += (t - m2) * (t - m2); rr += t * t; }
              atomicAdd(dbg + 6, ee); atomicAdd(dbg + 7, rr); }
          if (slot == 7) { float mn = 1e30f; int ns = 0; for (int q = tid; q < SEQ; q += NTHR) if (INV[(size_t)(b * SEQ + q) * NEXP + e] >= 0) { ++ns; mn = fminf(mn, AFF[(size_t)(b * NEXP + e) * SEQ + q]); }
              for (int o = 1; o < 64; o <<= 1) { mn = fminf(mn, shx(mn, o, F.lane)); ns += (int)shxu((unsigned)ns, o, F.lane); }
              __syncthreads(); if (F.lane == 0) { red[40 + F.wave] = mn; red[48 + F.wave] = (float)ns; } __syncthreads();
              float gmn = 1e30f; int gns = 0; for (int w = 0; w < 8; ++w) { gmn = fminf(gmn, red[40 + w]); gns += (int)red[48 + w]; }
              int bad = 0; for (int q = tid; q < SEQ; q += NTHR) if (INV[(size_t)(b * SEQ + q) * NEXP + e] < 0 && AFF[(size_t)(b * NEXP + e) * SEQ + q] > gmn) ++bad;
              if (bad > 0) atomicAdd(dbg + 9, (float)bad); if (tid == 0 && gns != 256) atomicAdd(dbg + 10, 1.0f); __syncthreads(); } }
        const float aff = AFF[(size_t)(b * NEXP + e) * SEQ + l];
        float e2 = 0.f, r2 = 0.f;
        for (int d = tid; d < DM; d += NTHR) { float y = 0.f; for (int f = 0; f < DM; ++f) y += hid[f] * wd[((size_t)e * DM + f) * DM + d]; y *= aff;
            const float mine = bf2f(YE[(size_t)(grp * CAP + slot) * DM + d]); const float yu = y / aff; e2 += (yu - mine) * (yu - mine); r2 += yu * yu; }
        if (tid == 0) { const float sa = ((const float*)(wsl + WS_SEL))[NSLOT + grp * CAP + slot]; if (fabsf(sa - aff) > 1e-6f) atomicAdd(dbg + 8, 1.0f); }
        e2 = wave_sum(e2, F.lane); r2 = wave_sum(r2, F.lane);
        __syncthreads();
        if (F.lane == 0) { atomicAdd(dbg + 0, e2); atomicAdd(dbg + 1, r2); }
        __syncthreads();
    }
}
#endif
__device__ __forceinline__ void combine_phase(const Args& A, Frame& F) {
    unsigned char* wsl = A.ws; asm volatile("" : "+s"(wsl));
    const float* AFFp = (const float*)(wsl + WS_AFF);
    const int* INV = (const int*)(wsl + WS_INV); const bf16* YE = (const bf16*)(wsl + WS_XE); bf16* XB = (bf16*)(wsl + WS_XB); float* IR3 = (float*)(wsl + WS_STAT) + (size_t)6 * TOK;
    const int gw = F.vcu * NWAVES + F.wave, NGW = F.G * NWAVES, lane = F.lane;
    for (int row = gw; row < TOK; row += NGW) {
        const int b = row >> 11; const int iv = INV[(size_t)row * NEXP + (lane & 15)];
        f32x4* xr = (f32x4*)(A.out + (size_t)row * DM) + lane;
        f32x4 v[4];
#pragma unroll
        for (int j = 0; j < 4; ++j) v[j] = xr[64 * j];
#pragma unroll
        for (int e = 0; e < 16; ++e) { const int slot = __builtin_amdgcn_readlane(iv, e);
            if (slot >= 0 && !((MK_DROP >> 4) & 1)) { const bf16* yr = YE + (size_t)((e * NB + b) * CAP + slot) * DM + 4 * lane; const float af = AFFp[(size_t)(b * NEXP + e) * SEQ + (row & 2047)];
#pragma unroll
                for (int j = 0; j < 4; ++j) v[j] += ld_bf16x4(yr + 256 * j) * af; } }
        float s = 0.f; u32x2* brow = (u32x2*)(XB + (size_t)row * DM) + lane;
#pragma unroll
        for (int j = 0; j < 4; ++j) { if (A.sub != 9) { xr[64 * j] = v[j]; brow[64 * j] = (u32x2){cvtpk(v[j].x, v[j].y), cvtpk(v[j].z, v[j].w)}; } s += (v[j].x * v[j].x + v[j].y * v[j].y) + (v[j].z * v[j].z + v[j].w * v[j].w); }
        s = wave_sum(s, F.lane);
        if (lane == 0) IR3[row] = rsqrtf(s * (1.0f / 1024.0f) + EPS);
    }
}
__device__ __forceinline__ void final_phase(const Args& A, Frame& F) {
    unsigned char* wsl = A.ws; asm volatile("" : "+s"(wsl));
    const f32x4* sp = (const f32x4*)(wsl + WS_SSP); const f32x4* fg = (const f32x4*)A.in[29] + F.lane;
    const int gw = F.vcu * NWAVES + F.wave, NGW = F.G * NWAVES;
    float dscale = 1.0f;
#if MK_DEBUG
    { const float* dbg = (const float*)(wsl + WS_CTL) + 1024; dscale = 1.0f + 10.0f * sqrtf(dbg[6] / fmaxf(dbg[7], 1e-30f)) + (dbg[9] > 0.f ? 1000.0f : 0.f) + (dbg[10] > 0.f ? 30000.0f : 0.f); }
#endif
    f32x4 g[4];
#pragma unroll
    for (int j = 0; j < 4; ++j) g[j] = fg[64 * j];
    for (int row = gw; row < TOK; row += NGW) {
        f32x4* xr = (f32x4*)(A.out + (size_t)row * DM) + F.lane; const f32x4 p0 = sp[4 * row], p1 = sp[4 * row + 1], p2 = sp[4 * row + 2], p3 = sp[4 * row + 3];
        const float ssr = (((p0.x + p0.y) + (p0.z + p0.w)) + ((p1.x + p1.y) + (p1.z + p1.w))) + (((p2.x + p2.y) + (p2.z + p2.w)) + ((p3.x + p3.y) + (p3.z + p3.w)));
        const float inv = rsqrtf(ssr * (1.0f / 1024.0f) + EPS);
#pragma unroll
        for (int j = 0; j < 4; ++j) { const f32x4 o = xr[64 * j] * (inv * dscale) * g[j]; if (A.sub != 9) xr[64 * j] = o; else asm volatile("" :: "v"(o)); }
    }
}

#ifndef MK_PER_PHASE
#define MK_PER_PHASE 0
#endif
constexpr int NPH = 26;
__global__ void __launch_bounds__(NTHR, 2) mk_fwd(Args A) {
    extern __shared__ __attribute__((aligned(16))) unsigned char lds_raw[];
    asm volatile("s_nop 0\n\ts_nop 0\n\ts_nop 0\n\ts_nop 0");
    Frame F;
    F.lds = (LAS unsigned char*)lds_raw;
    F.tid = threadIdx.x; F.lane = F.tid & 63; F.wave = __builtin_amdgcn_readfirstlane(F.tid >> 6);
    F.G = gridDim.x; { const int bx = blockIdx.x; F.vcu = (F.G % 8 == 0) ? (bx % 8) * (F.G / 8) + bx / 8 : bx; }
    volatile LAS unsigned* MISC = (volatile LAS unsigned*)(F.lds + LDSCTL_OFF);
    if (F.tid < 64) MISC[F.tid] = 0u;
    __syncthreads();
    const int lo = A.ph_lo, hi = A.ph_hi;
    unsigned* ctl = (unsigned*)(A.ws + WS_CTL);
    XcdBarrier bar; bar.bar = ctl + CW_BAR + A.bar_idx * XCD_BAR_WORDS; bar.x = 0; bar.st = nullptr;
    if (hi - lo > 1) bar = xcd_barrier_post(ctl + CW_BAR + A.bar_idx * XCD_BAR_WORDS, MISC + 8);
#ifndef MK_MASK
#define MK_MASK 0xFFFFFFu
#endif
#define KIND(j) (((MK_MASK) >> (j)) & 1u)
#define REFRESH() do { int l_; asm volatile("v_mbcnt_lo_u32_b32 %0, -1, 0\n\tv_mbcnt_hi_u32_b32 %0, -1, %0" : "=v"(l_)); l_ &= 63; F.lane = l_; F.tid = F.wave * 64 + l_; } while (0)
    LAS unsigned char* ring = F.lds;
    for (int ph = lo; ph < hi; ++ph) {
        const int li = ph >= 13 ? 1 : 0, kk = (ph == 0) ? 12 : (ph == 25 ? 13 : ph - 1 - 12 * li);
        unsigned char* ws = A.ws; asm volatile("" : "+s"(ws));
        if (kk == 12) { if (KIND(0)) { REFRESH(); phase_p0(A, F); } }
        else if (kk == 0) { if (KIND(1)) { REFRESH(); phase_l0a(A, F, li); } }
        else if (kk == 1) { if (KIND(2)) {
            REFRESH();
            filter_fft(A, F, (int)blockIdx.x, (int)F.G);
            __syncthreads();
            pg8::Gemm g{(const bf16*)(ws + WS_XB), (const bf16*)(ws + WS_WIN), TOK, NWIN, DM}; pg8::StaticOrder S; S.init(TOK, NWIN, F.G, (int)blockIdx.x);
            EpiWin E{(const float*)(ws + WS_STAT) + (size_t)li * TOK, A.in[4] + li * 4096, ws};
            pg8::gemm_phase<EpiWin, pg8::StaticOrder, true, true>(ring, g, S, E, F.wave); } }
        else if (kk == 2) {
            const int sub = A.sub;
            REFRESH();
            if (KIND(14) || KIND(15)) fft_init_tw(A, F);
            if (KIND(14) && (sub == 0 || sub == 1)) hyena_phase(A, F, li);
            REFRESH();
            if (KIND(15) && (sub == 0 || sub == 2)) fnet_phase(A, F);
            __syncthreads();
            REFRESH();
            if (KIND(16) && (sub == 0 || sub == 3)) na_phase(A, F, li);
            __syncthreads();
            if (KIND(17) && (sub == 0 || sub == 4)) { pg8::Gemm g{(const bf16*)(ws + WS_CQ), (const bf16*)(ws + WS_WUQ), TOK, 512, 256}; pg8::StaticOrder S; S.init(TOK, 512, F.G, (int)blockIdx.x);
              EpiQ E{ws}; pg8::gemm_phase<EpiQ, pg8::StaticOrder, true, true>(ring, g, S, E, F.wave); }
            if (KIND(18) && (sub == 0 || sub == 4)) { pg8::Gemm g{(const bf16*)(ws + WS_CKV), (const bf16*)(ws + WS_WUKV), TOK, 512, 256}; pg8::StaticOrder S; S.init(TOK, 512, F.G, (int)((blockIdx.x + F.G / 2) % F.G));
              EpiKV E{ws}; pg8::gemm_phase<EpiKV, pg8::StaticOrder, true, true>(ring, g, S, E, F.wave); } }
        else if (kk == 3) { if (KIND(4)) { REFRESH(); mla_attn_phase(A, F); } }
        else if (kk == 4) { if (KIND(5)) {
            pg8::Gemm g{(const bf16*)(ws + WS_YHY), (const bf16*)(ws + WS_WBR), TOK, DM, 256}; BranchOrder S; S.so.init(TOK, DM, F.G, (int)blockIdx.x);
            EpiBranch E{ws}; pg8::gemm_phase<EpiBranch, BranchOrder, true, true>(ring, g, S, E, F.wave); } }
        else if (kk == 5) { if (KIND(6)) {
            pg8::Gemm g{(const bf16*)(ws + WS_MERGED), (const bf16*)(ws + WS_WOUT), TOK, DM, DM}; pg8::StaticOrder S; S.init(TOK, DM, F.G, (int)blockIdx.x);
            EpiResid E{ws, A.out, A.sub == 9, li == 0 ? A.in[0] : (const float*)A.out}; pg8::gemm_phase<EpiResid, pg8::StaticOrder, true, true>(ring, g, S, E, F.wave); } }
        else if (kk == 6) { if (KIND(7)) { REFRESH(); router_phase(A, F, li); } }
        else if (kk == 7) { if (KIND(8)) { REFRESH(); topk_phase(A, F); } }
        else if (kk == 8) { if (KIND(9)) {
            pg8::Gemm g{(const bf16*)(ws + WS_XE), (const bf16*)(ws + WS_WE1), NSLOT, NEXP * 2048, DM}; MoeOrder S{F.G, (int)blockIdx.x, 8, 1024};
            EpiSwiglu E{ws}; pg8::gemm_phase<EpiSwiglu, MoeOrder, true, true>(ring, g, S, E, F.wave); } }
        else if (kk == 9) { if (KIND(10)) {
            pg8::Gemm g{(const bf16*)(ws + WS_HB), (const bf16*)(ws + WS_WE2), NSLOT, NEXP * 1024, DM}; MoeOrder S{F.G, (int)blockIdx.x, 4, 512};
            EpiDown E{ws}; pg8::gemm_phase<EpiDown, MoeOrder, true, true>(ring, g, S, E, F.wave); } }
        else if (kk == 10) { if (KIND(11)) { REFRESH(); combine_phase(A, F); } }
        else if (kk == 11) { if (KIND(12)) {
            { pg8::Gemm g{(const bf16*)(ws + WS_PB), (const bf16*)(ws + WS_WPP), TOK, DM, 256}; pg8::StaticOrder S; S.init(TOK, DM, F.G, (int)blockIdx.x);
              EpiPP E{ws}; pg8::gemm_phase<EpiPP, pg8::StaticOrder, true, true>(ring, g, S, E, F.wave); }
            { pg8::Gemm g{(const bf16*)(ws + WS_XB), (const bf16*)(ws + WS_WPG), TOK, DM, DM}; pg8::StaticOrder S; S.init(TOK, DM, F.G, (int)blockIdx.x);
              EpiPle E{ws, A.out, (float*)(ws + WS_SSP), A.sub == 9}; pg8::gemm_phase<EpiPle, pg8::StaticOrder, true, true>(ring, g, S, E, F.wave); } } }
        else { if (KIND(13)) { REFRESH(); final_phase(A, F); } }
        if (ph + 1 < hi) xcd_barrier(bar, F.wave);
    }
#undef KIND
#undef REFRESH
}

extern "C" void kernel_launch(void* const* d_in, const int* in_sizes, int n_in, void* d_out, int out_size, void* d_ws, size_t ws_size, hipStream_t stream) {
    static int grid = 0;
    if (grid == 0) {
        if (n_in != 30 || in_sizes[0] != TOK * DM || out_size != TOK * DM || ws_size < WS_END) {
            fprintf(stderr, "kernel_launch: unexpected problem (n_in %d, in0 %d, out %d, ws %zu < %zu); nothing launched\n", n_in, n_in > 0 ? in_sizes[0] : -1, out_size, ws_size, (size_t)WS_END); grid = -1; return; }
        int dev = 0, cus = 0, per_cu = 0;
        if (hipGetDevice(&dev) != hipSuccess || hipDeviceGetAttribute(&cus, hipDeviceAttributeMultiprocessorCount, dev) != hipSuccess) { fprintf(stderr, "kernel_launch: device query failed\n"); grid = -1; return; }
        if (hipFuncSetAttribute((const void*)mk_fwd, hipFuncAttributeMaxDynamicSharedMemorySize, LDS_BYTES) != hipSuccess) { fprintf(stderr, "kernel_launch: hipFuncSetAttribute failed\n"); grid = -1; return; }
        if (hipOccupancyMaxActiveBlocksPerMultiprocessor(&per_cu, (const void*)mk_fwd, NTHR, LDS_BYTES) != hipSuccess || per_cu < 1)
            fprintf(stderr, "kernel_launch: note: occupancy query reports %d workgroups per CU\n", per_cu);
        (void)hipGetLastError();
        grid = cus;
    }
    if (grid < 0) return;
    if (hipMemsetAsync((char*)d_ws + WS_CTL, 0, CTL_ZERO_BYTES, stream) != hipSuccess) { fprintf(stderr, "kernel_launch: memset failed\n"); return; }
    Args a{};
    for (int i = 0; i < 30; ++i) a.in[i] = (const float*)d_in[i];
    a.out = (float*)d_out; a.ws = (unsigned char*)d_ws;
#if MK_PER_PHASE
    for (int p = 0; p < NPH; ++p) { a.ph_lo = p; a.ph_hi = p + 1; hipLaunchKernelGGL(mk_fwd, dim3(grid), dim3(NTHR), LDS_BYTES, stream, a); }
#elif defined(MK_PROBE_A)
    {
        const int cuts[6] = {0, MK_PROBE_A, MK_PROBE_A + 1, MK_PROBE_B, MK_PROBE_B + 1, NPH}; int bi = 0;
        for (int s = 0; s < 5; ++s) { const int reps = (s == 1 || s == 3) ? 2 : 1;
            for (int r = 0; r < reps; ++r) { a.ph_lo = cuts[s]; a.ph_hi = cuts[s + 1]; a.bar_idx = bi++; a.sub = (r == 1) ? MK_PROBE_SUB : 0; if (a.ph_hi > a.ph_lo) hipLaunchKernelGGL(mk_fwd, dim3(grid), dim3(NTHR), LDS_BYTES, stream, a); } }
    }
#else
    a.ph_lo = 0; a.ph_hi = NPH;
    hipLaunchKernelGGL(mk_fwd, dim3(grid), dim3(NTHR), LDS_BYTES, stream, a);
#endif
    const hipError_t le = hipPeekAtLastError();
    if (le != hipSuccess) fprintf(stderr, "kernel_launch: launch failed: %s\n", hipGetErrorName(le));
}
```

```cpp
#include <hip/hip_runtime.h>
#include <cstdio>
#include <cstdint>
namespace pg8 {
#define PG8_LAS __attribute__((address_space(3)))
typedef unsigned short bf16_t;
typedef short bf16x8 __attribute__((ext_vector_type(8)));
typedef float f32x4 __attribute__((ext_vector_type(4)));
typedef unsigned u32x4 __attribute__((ext_vector_type(4)));
constexpr int BM = 256, BK = 64, HALF = 128, HTB = HALF * BK * 2  , STAGE_BYTES = 8 * HTB, NXCD = 8, WGM = 8;

__host__ __device__ __forceinline__ int lds_byte(int r, int c) { const int st = (r >> 4) * 2 + (c >> 5), rr = r & 15, cc = c & 31, ob = rr * 64 + cc * 2; return st * 1024 + (ob ^ (((ob >> 9) & 1) << 5)); }
__host__ __device__ __forceinline__ void stage_rc(int b, int& R, int& C) { const int st = b / 1024, sb = b % 1024, swz = sb ^ (((sb >> 9) & 1) << 5); R = (st >> 1) * 16 + swz / 64; C = (st & 1) * 32 + (swz % 64) / 2; }
__host__ __device__ __forceinline__ int perm32(int rho) { const int n = rho >> 4, i = rho & 15; return 8 * (i >> 2) + 4 * n + (i & 3); }

struct Unit { int pm, pn, aux; };
struct Gemm { const bf16_t* A; const bf16_t* Bt; int M, N, K; };

struct StaticOrder {
    int nM, nN, nwg, G, c;
    __host__ __device__ void init(int M, int N, int G_, int c_) { nM = M / BM; nN = N / BM; nwg = nM * nN; G = G_; c = c_; }
    __host__ __device__ __forceinline__ bool next(int i, Unit& u) const {
        const long L = (long)i * G + c; if (L >= nwg) return false;
        int wgid = (int)L; { const int q = nwg / NXCD, r = nwg % NXCD, xcd = wgid % NXCD, off = wgid / NXCD; wgid = (xcd < r ? xcd * (q + 1) : r * (q + 1) + (xcd - r) * q) + off; }
        const int nig = WGM * nN, gid = wgid / nig, fm = gid * WGM, gsz = (nM - fm) < WGM ? (nM - fm) : WGM;
        u.pm = fm + ((wgid % nig) % gsz); u.pn = (wgid % nig) / gsz; return true;
    }
    __device__ __forceinline__ void ptrs(const Gemm& g, const Unit& u, size_t tstep, const char*& a, const char*& b) const { a = (const char*)g.A + (size_t)u.pm * tstep; b = (const char*)g.Bt + (size_t)u.pn * tstep; }
    __device__ __forceinline__ void a_ready(const Unit&) const {}
    __device__ __forceinline__ void done(const Unit&) const {}
};
__device__ __forceinline__ unsigned cvt_pk_bf16(float lo, float hi) { unsigned r; asm volatile("v_cvt_pk_bf16_f32 %0, %1, %2" : "=v"(r) : "v"(lo), "v"(hi)); return r; }
template <class Epi, class Sched, bool ALIGN_EPI = false, bool SP2 = false>
__device__ __forceinline__ void gemm_phase(PG8_LAS unsigned char* lds, const Gemm g, const Sched& S, const Epi& E, int wave_id) {
    int lane_; asm volatile("v_mbcnt_lo_u32_b32 %0, -1, 0\n\tv_mbcnt_hi_u32_b32 %0, -1, %0" : "=v"(lane_));
    lane_ &= 63; const int tid = wave_id * 64 + lane_, wid = __builtin_amdgcn_readfirstlane(tid >> 6), lane = tid & 63, wr = wid >> 2, wc = wid & 3, fr = lane & 15, fq = lane >> 4;
    int K_ = g.K; asm volatile("" : "+s"(K_));
    const int K = K_, nt = K / BK;
    unsigned voffA[2], voffB[2];
#pragma unroll
    for (int i = 0; i < 2; ++i) { int R, C; stage_rc(tid * 16 + i * 8192, R, C); const int Rb = Epi::PERM ? ((R & ~31) + perm32(R & 31)) : R;
        voffA[i] = (unsigned)(R * K + C) * 2u; voffB[i] = (unsigned)(Rb * K + C) * 2u; }
    const size_t kstep = (size_t)(BK * 2);
    const size_t hstep = (size_t)HALF * K * 2;
    const size_t tstep = 2 * hstep;
    const unsigned ldsw = (unsigned)wid * 1024u;
    const int aoff = lds_byte(wr * 64 + fr, fq * 8), boff = lds_byte(wc * 32 + fr, fq * 8);
#define PG8_SA(b, h) (((b) * 2 + (h)) * HTB)
#define PG8_SB(b, h) ((4 + (b) * 2 + (h)) * HTB)
#define PG8_STAGE(bufoff, gbase, voff) do { _Pragma("unroll") for (int _i = 0; _i < 2; ++_i) \
        __builtin_amdgcn_global_load_lds((const unsigned*)((const char*)(gbase) + (voff)[_i]), (PG8_LAS unsigned*)(lds + (bufoff) + ldsw + _i * 8192), 16, 0, 0); } while (0)
#define PG8_LDA(dst, b, h) do { _Pragma("unroll") for (int m = 0; m < 4; ++m) _Pragma("unroll") for (int k = 0; k < 2; ++k) dst[m][k] = *(const PG8_LAS bf16x8*)(lds + PG8_SA(b, h) + aoff + m * 2048 + k * 1024); } while (0)
#define PG8_LDB(dst, b, h) do { _Pragma("unroll") for (int n = 0; n < 2; ++n) _Pragma("unroll") for (int k = 0; k < 2; ++k) dst[n][k] = *(const PG8_LAS bf16x8*)(lds + PG8_SB(b, h) + boff + n * 2048 + k * 1024); } while (0)
#define PG8_MMA(ai, bj, At, Bt) do { __builtin_amdgcn_s_setprio(1); _Pragma("unroll") for (int m = 0; m < 4; ++m) _Pragma("unroll") for (int n = 0; n < 2; ++n) _Pragma("unroll") for (int k = 0; k < 2; ++k) \
        acc[ai][bj][m][n] = __builtin_amdgcn_mfma_f32_16x16x32_bf16(Bt[n][k], At[m][k], acc[ai][bj][m][n], 0, 0, 0); __builtin_amdgcn_s_setprio(0); } while (0)
#define PG8_WAIT_V(n) asm volatile("s_waitcnt vmcnt(" #n ")" ::: "memory")
#define PG8_WAIT_L(n) asm volatile("s_waitcnt lgkmcnt(" #n ")" ::: "memory")
#define PG8_BAR __builtin_amdgcn_s_barrier()
#define PG8_SCHED __builtin_amdgcn_sched_barrier(0)
    Unit cur, nxt; int ui = 0;
    if (!S.next(0, cur)) return;
    f32x4 acc[2][2][4][2];
#pragma unroll
    for (int a = 0; a < 2; ++a)
#pragma unroll
        for (int b = 0; b < 2; ++b)
#pragma unroll
            for (int m = 0; m < 4; ++m)
#pragma unroll
                for (int n = 0; n < 2; ++n) acc[a][b][m][n] = (f32x4){0.f, 0.f, 0.f, 0.f};
    bf16x8 At[4][2], B0[2][2], B1[2][2];
    const char* cA; const char* cB; S.ptrs(g, cur, tstep, cA, cB);
    S.a_ready(cur);
    if constexpr (SP2) {
        PG8_STAGE(PG8_SB(0, 0), cB, voffB); PG8_STAGE(PG8_SB(0, 1), cB + hstep, voffB); PG8_STAGE(PG8_SA(0, 0), cA, voffA); PG8_STAGE(PG8_SA(0, 1), cA + hstep, voffA);
        if (wr == 1) PG8_BAR;
        PG8_WAIT_V(2); PG8_BAR;
        PG8_STAGE(PG8_SB(1, 0), cB + kstep, voffB); PG8_STAGE(PG8_SA(1, 0), cA + kstep, voffA); PG8_STAGE(PG8_SB(1, 1), cB + hstep + kstep, voffB);
        PG8_WAIT_V(6); PG8_BAR;
    } else {
        PG8_STAGE(PG8_SB(0, 0), cB, voffB); PG8_STAGE(PG8_SA(0, 0), cA, voffA); PG8_STAGE(PG8_SB(0, 1), cB + hstep, voffB); PG8_STAGE(PG8_SA(0, 1), cA + hstep, voffA);
        if (wr == 1) PG8_BAR;
        PG8_WAIT_V(4); PG8_BAR;
        PG8_STAGE(PG8_SB(1, 0), cB + kstep, voffB); PG8_STAGE(PG8_SA(1, 0), cA + kstep, voffA); PG8_STAGE(PG8_SB(1, 1), cB + hstep + kstep, voffB);
        PG8_WAIT_V(6); PG8_BAR;
    }
    for (;;) {
        const bool has_next = S.next(ui + 1, nxt);
        const char* nA = cA; const char* nB = cB; if (has_next) S.ptrs(g, nxt, tstep, nA, nB);
        for (int t = 0; t < nt; t += 2) {
            const bool last = (t == nt - 2);
            const char* a1 = cA + (size_t)(t + 1) * kstep;
            const char* a2 = last ? nA : cA + (size_t)(t + 2) * kstep; const char* b2 = last ? nB : cB + (size_t)(t + 2) * kstep;
            const char* a3 = a2 + kstep; const char* b3 = b2 + kstep;
            if (last && has_next) S.a_ready(nxt);
            if constexpr (SP2) {
            PG8_LDB(B0, 0, 0); PG8_LDB(B1, 0, 1); PG8_SCHED; PG8_LDA(At, 0, 0); PG8_STAGE(PG8_SA(1, 1), a1 + hstep, voffA);
            PG8_WAIT_V(8); PG8_WAIT_L(0); PG8_BAR; PG8_MMA(0, 0, At, B0); if constexpr (!Epi::HALFN) PG8_MMA(0, 1, At, B1); PG8_BAR; PG8_SCHED;
            PG8_LDA(At, 0, 1); PG8_STAGE(PG8_SB(0, 0), b2, voffB); PG8_STAGE(PG8_SB(0, 1), b2 + hstep, voffB); PG8_STAGE(PG8_SA(0, 0), a2, voffA);
            PG8_WAIT_V(8); PG8_WAIT_L(0); PG8_BAR; PG8_MMA(1, 0, At, B0); if constexpr (!Epi::HALFN) PG8_MMA(1, 1, At, B1); PG8_BAR; PG8_SCHED;
            PG8_LDB(B0, 1, 0); PG8_LDB(B1, 1, 1); PG8_SCHED; PG8_LDA(At, 1, 0); PG8_STAGE(PG8_SA(0, 1), a2 + hstep, voffA);
            PG8_WAIT_V(8); PG8_WAIT_L(0); PG8_BAR; PG8_MMA(0, 0, At, B0); if constexpr (!Epi::HALFN) PG8_MMA(0, 1, At, B1); PG8_BAR; PG8_SCHED;
            PG8_LDA(At, 1, 1); PG8_STAGE(PG8_SB(1, 0), b3, voffB); PG8_STAGE(PG8_SB(1, 1), b3 + hstep, voffB); PG8_STAGE(PG8_SA(1, 0), a3, voffA);
            PG8_WAIT_V(8); PG8_WAIT_L(0); PG8_BAR; PG8_MMA(1, 0, At, B0); if constexpr (!Epi::HALFN) PG8_MMA(1, 1, At, B1); PG8_BAR; PG8_SCHED;
            } else {
            PG8_LDB(B0, 0, 0); PG8_SCHED; PG8_LDA(At, 0, 0); PG8_STAGE(PG8_SA(1, 1), a1 + hstep, voffA);
            PG8_WAIT_L(8); PG8_BAR; PG8_WAIT_L(0); PG8_MMA(0, 0, At, B0); PG8_BAR; PG8_SCHED;
            PG8_LDB(B1, 0, 1); PG8_STAGE(PG8_SB(0, 0), b2, voffB);
            PG8_BAR; PG8_WAIT_L(0); PG8_MMA(0, 1, At, B1); PG8_BAR;
            PG8_LDA(At, 0, 1); PG8_STAGE(PG8_SA(0, 0), a2, voffA);
            PG8_BAR; PG8_WAIT_L(0); PG8_MMA(1, 0, At, B0); PG8_BAR; PG8_SCHED;
            PG8_STAGE(PG8_SB(0, 1), b2 + hstep, voffB);
            PG8_WAIT_V(6); PG8_BAR; PG8_MMA(1, 1, At, B1); PG8_BAR;
            PG8_LDB(B0, 1, 0); PG8_SCHED; PG8_LDA(At, 1, 0); PG8_STAGE(PG8_SA(0, 1), a2 + hstep, voffA);
            PG8_WAIT_L(8); PG8_BAR; PG8_WAIT_L(0); PG8_MMA(0, 0, At, B0); PG8_BAR; PG8_SCHED;
            PG8_LDB(B1, 1, 1); PG8_STAGE(PG8_SB(1, 0), b3, voffB);
            PG8_BAR; PG8_WAIT_L(0); PG8_MMA(0, 1, At, B1); PG8_BAR;
            PG8_LDA(At, 1, 1); PG8_STAGE(PG8_SA(1, 0), a3, voffA);
            PG8_BAR; PG8_WAIT_L(0); PG8_MMA(1, 0, At, B0); PG8_BAR; PG8_SCHED;
            PG8_STAGE(PG8_SB(1, 1), b3 + hstep, voffB);
            PG8_WAIT_V(6); PG8_BAR; PG8_MMA(1, 1, At, B1); PG8_BAR;
            }
        }
        if constexpr (ALIGN_EPI) { if (wr == 0) PG8_BAR; }
        if constexpr (!Epi::AFTER_DRAIN) { E(acc, cur, wr, wc, fr, fq); S.done(cur); }
        if (!has_next) break;
#pragma unroll
        for (int a = 0; a < 2; ++a)
#pragma unroll
            for (int b = 0; b < (Epi::HALFN ? 1 : 2); ++b)
#pragma unroll
                for (int m = 0; m < 4; ++m)
#pragma unroll
                    for (int n = 0; n < 2; ++n) acc[a][b][m][n] = (f32x4){0.f, 0.f, 0.f, 0.f};
        cur = nxt; cA = nA; cB = nB; ++ui;
        if constexpr (ALIGN_EPI) { if (wr == 1) PG8_BAR; }
    }
    PG8_WAIT_V(0);
    if constexpr (!ALIGN_EPI) { if (wr == 0) PG8_BAR; }
    PG8_BAR;
    if constexpr (Epi::AFTER_DRAIN) { E.fused(acc, cur, wr, wc, fr, fq, lds, wid, lane); S.done(cur); }
#undef PG8_SA
#undef PG8_SB
#undef PG8_STAGE
#undef PG8_LDA
#undef PG8_LDB
#undef PG8_MMA
#undef PG8_WAIT_V
#undef PG8_WAIT_L
#undef PG8_BAR
#undef PG8_SCHED
}
}
#define GAS __attribute__((address_space(1)))
#define LAS __attribute__((address_space(3)))
typedef unsigned short bf16;
typedef unsigned v4u __attribute__((ext_vector_type(4)));
typedef float f32x4 __attribute__((ext_vector_type(4)));
typedef short bf16x8 __attribute__((ext_vector_type(8)));
typedef GAS unsigned gu32;
typedef GAS unsigned long long gu64;
#define RLX_AGENT __ATOMIC_RELAXED, __HIP_MEMORY_SCOPE_AGENT
#define LDS_WAIT() asm volatile("s_waitcnt lgkmcnt(0)" ::: "memory")
#define VM_WAIT() asm volatile("s_waitcnt vmcnt(0)" ::: "memory")
__device__ __forceinline__ unsigned long long rt() { return __builtin_amdgcn_s_memrealtime(); }
__device__ __forceinline__ unsigned f2bf(float f) { unsigned u = __builtin_bit_cast(unsigned, f); return (u + 0x7fffu + ((u >> 16) & 1u)) >> 16; }
__device__ __forceinline__ unsigned pk2(float lo, float hi) { return f2bf(lo) | (f2bf(hi) << 16); }
#define XB_TMO      128
#define XB_XCNT(j)  (256  + 64 * (j))
#define XB_XSUB(j)  (1280 + 64 * (j))
#define XB_XGEN(j)  (2304 + 64 * (j))
#define XB_TOP      3328
#define XB_TOPGEN   3392
#define XCD_BAR_WORDS 3456
#define XB_SPIN_CAP (1u << 18)

__device__ __forceinline__ unsigned xb_ld(unsigned* p)              { return __hip_atomic_load(p, __ATOMIC_RELAXED, __HIP_MEMORY_SCOPE_AGENT); }
__device__ __forceinline__ unsigned xb_add(unsigned* p, unsigned v) { return __hip_atomic_fetch_add(p, v, __ATOMIC_RELAXED, __HIP_MEMORY_SCOPE_AGENT); }
__device__ __forceinline__ unsigned xb_xcc_id() { return (unsigned)__builtin_amdgcn_s_getreg((3 << 11) | 20) & 0xFu; }
#define XB_SPIN(cond, bar) do { unsigned _sp = 0; while (cond) { __builtin_amdgcn_s_sleep(1); \
    if ((++_sp & 255u) == 0u) { if (xb_ld(&(bar)[XB_TMO])) break; if (_sp > XB_SPIN_CAP) { atomicAdd(&(bar)[XB_TMO], 1u); break; } } } } while (0)

struct XcdBarrier {
    unsigned* bar; unsigned x;
    volatile LAS unsigned* st;
};

__device__ __forceinline__ XcdBarrier xcd_barrier_post(unsigned* bar, volatile LAS unsigned* st) {
    XcdBarrier b; b.bar = bar; b.x = xb_xcc_id(); b.st = st;
    if (threadIdx.x == 0) (void)xb_add(&bar[XB_XCNT(b.x)], 1u);
    return b;
}
__device__ __forceinline__ void xcd_barrier_complete(unsigned* bar, unsigned x, unsigned& nloc, unsigned& nx) {
    const unsigned G = gridDim.x * gridDim.y * gridDim.z;
    unsigned sum, cnt, mine, sp = 0u;
    for (;;) {
        sum = 0u; cnt = 0u; mine = 0u;
#pragma unroll
        for (unsigned j = 0; j < 16; ++j) { const unsigned c = xb_ld(&bar[XB_XCNT(j)]); sum += c; cnt += (c > 0u) ? 1u : 0u; mine = (j == x) ? c : mine; }
        if (sum == G) break;
        __builtin_amdgcn_s_sleep(1);
        if ((++sp & 255u) == 0u) { if (xb_ld(&bar[XB_TMO])) break; if (sp > XB_SPIN_CAP) { atomicAdd(&bar[XB_TMO], 1u); break; } }
    }
    nloc = mine > 0u ? mine : 1u; nx = cnt > 0u ? cnt : 1u;
}

__device__ __forceinline__ void xcd_barrier(const XcdBarrier& b, int wave_id) {
    asm volatile("s_waitcnt vmcnt(0)" ::: "memory");
    __syncthreads();
    int l0_; asm volatile("v_mbcnt_lo_u32_b32 %0, -1, 0\n\tv_mbcnt_hi_u32_b32 %0, -1, %0" : "=v"(l0_));
    if (wave_id == 0 && l0_ == 0) {
        unsigned* bar = b.bar;
        __builtin_amdgcn_s_waitcnt(0);
        unsigned nloc = b.st[0], nx = b.st[1];
        if (nloc == 0u) { xcd_barrier_complete(bar, b.x, nloc, nx); b.st[0] = nloc; b.st[1] = nx; }
        const unsigned old = xb_add(&bar[XB_XSUB(b.x)], 1u);
        const unsigned gen = old / nloc;
        if (old + 1u == (gen + 1u) * nloc) {
            __builtin_amdgcn_fence(__ATOMIC_RELEASE, "agent");
            asm volatile("s_waitcnt vmcnt(0)" ::: "memory");
            const unsigned og = xb_add(&bar[XB_TOP], 1u);
            const unsigned tg = og / nx;
            if (og + 1u == (tg + 1u) * nx) xb_add(&bar[XB_TOPGEN], 1u);
            else XB_SPIN(xb_ld(&bar[XB_TOPGEN]) == tg, bar);
            __builtin_amdgcn_fence(__ATOMIC_ACQUIRE, "agent");
            xb_add(&bar[XB_XGEN(b.x)], 1u);
            asm volatile("s_waitcnt vmcnt(0)" ::: "memory");
        } else {
            XB_SPIN(xb_ld(&bar[XB_XGEN(b.x)]) == gen, bar);
            __builtin_amdgcn_fence(__ATOMIC_ACQUIRE, "agent");
            asm volatile("s_waitcnt vmcnt(0)" ::: "memory");
        }
    }
    __syncthreads();
}

constexpr int NWAVES = 8, NTHR = 512;
constexpr int NB = 8, SEQ = 2048, DM = 1024, TOK = NB * SEQ;
constexpr int IN_COLS = 6304, NWIN = 6400;
constexpr int NEXP = 16, CAP = 256, NSLOT = NB * NEXP * CAP;
constexpr float EPS = 1e-6f;
constexpr float LOG2E = 1.4426950408889634f;
typedef float f32x16 __attribute__((ext_vector_type(16)));
typedef float f32x2 __attribute__((ext_vector_type(2)));
typedef unsigned u32x2 __attribute__((ext_vector_type(2)));

constexpr size_t MiB = 1u << 20;
constexpr size_t WS_CTL = 0, CTL_ZERO_BYTES = 1 * MiB;
constexpr size_t WS_STAT = 1 * MiB;
constexpr size_t WS_SSP = 29 * MiB;
constexpr size_t WS_AFF = 2 * MiB;
constexpr size_t WS_INV = 3 * MiB;
constexpr size_t WS_SEL = 4 * MiB;
constexpr size_t WS_ROPE = 4 * MiB + 512 * 1024;
constexpr size_t WS_KT = 5 * MiB;
constexpr size_t WS_KF = 13 * MiB;
constexpr size_t WS_WIN = 32 * MiB;
constexpr size_t WS_WUQ = 45 * MiB;
constexpr size_t WS_WUKV = WS_WUQ + 512 * 256 * 2;
constexpr size_t WS_WBR = 46 * MiB;
constexpr size_t WS_WOUT = 48 * MiB;
constexpr size_t WS_WPG = 50 * MiB;
constexpr size_t WS_WPP = 52 * MiB;
constexpr size_t WS_WE1 = 54 * MiB;
constexpr size_t WS_WE2 = 118 * MiB;
constexpr size_t WS_XB = 150 * MiB;
constexpr size_t WS_PB = 182 * MiB;
constexpr size_t WS_UHYT = 190 * MiB;
constexpr size_t WS_UFNT = 214 * MiB;
constexpr size_t WS_CQ = 222 * MiB;
constexpr size_t WS_CKV = 230 * MiB;
constexpr size_t WS_NAQ = 238 * MiB;
constexpr size_t WS_NAK = 246 * MiB;
constexpr size_t WS_NAVT = 254 * MiB;
constexpr size_t WS_MPART = 190 * MiB;
constexpr size_t WS_GATES = 262 * MiB;
constexpr size_t WS_XE = 262 * MiB;
constexpr size_t WS_HB = 326 * MiB;
constexpr size_t WS_Q = 390 * MiB;
constexpr size_t WS_KFULL = 402 * MiB;
constexpr size_t WS_VT = 414 * MiB;
constexpr size_t WS_YHY = 422 * MiB, WS_YFN = 430 * MiB, WS_YMLA = 438 * MiB, WS_YNA = 446 * MiB;
constexpr size_t WS_MERGED = 454 * MiB;
constexpr size_t WS_PP = 486 * MiB;
constexpr size_t WS_END = 518 * MiB;
constexpr int CW_TMO = 0, CW_BAR = 4096;

constexpr int RING_BYTES = 131072;
constexpr int LDS_BYTES = 147456;
constexpr int LDSCTL_OFF = LDS_BYTES - 256;

struct Args {
    const float* in[30]; float* out; unsigned char* ws; int ph_lo, ph_hi, bar_idx, sub;
};
struct Frame {
    LAS unsigned char* lds;
    int tid, lane, wave, vcu, G;

};

__device__ __forceinline__ float bf2f(unsigned short h) { return __builtin_bit_cast(float, (unsigned)h << 16); }
__device__ __forceinline__ unsigned cvtpk(float lo, float hi) { return pg8::cvt_pk_bf16(lo, hi); }
__device__ __forceinline__ float shx(float v, int mask, int lane) { return __builtin_bit_cast(float, __builtin_amdgcn_ds_bpermute((lane ^ mask) << 2, __builtin_bit_cast(int, v))); }
__device__ __forceinline__ unsigned shxu(unsigned v, int mask, int lane) { return (unsigned)__builtin_amdgcn_ds_bpermute((lane ^ mask) << 2, (int)v); }
__device__ __forceinline__ float shl_from(float v, int src_lane) { return __builtin_bit_cast(float, __builtin_amdgcn_ds_bpermute(src_lane << 2, __builtin_bit_cast(int, v))); }
__device__ __forceinline__ unsigned shlu_from(unsigned v, int src_lane) { return (unsigned)__builtin_amdgcn_ds_bpermute(src_lane << 2, (int)v); }
__device__ __forceinline__ float wave_sum(float v, int lane) {
#pragma unroll
    for (int o = 1; o < 64; o <<= 1) v += shx(v, o, lane);
    return v;
}
__device__ __forceinline__ float fast_exp2(float x) { return __builtin_amdgcn_exp2f(x); }
__device__ __forceinline__ float sigmoidf_(float x) { return 1.0f / (1.0f + __expf(-x)); }

__device__ __forceinline__ int fpad(int i) { return i + (i >> 3); }
__device__ __forceinline__ f32x2 cmul(f32x2 a, f32x2 b) { return (f32x2){a.x * b.x - a.y * b.y, a.x * b.y + a.y * b.x}; }
__device__ __forceinline__ f32x2 cmulc(f32x2 a, f32x2 b) { return (f32x2){a.x * b.x + a.y * b.y, a.y * b.x - a.x * b.y}; }
template <bool INV> __device__ __forceinline__ void dft8(f32x2 (&x)[8]) {
    const float R = 0.70710678118654752f;
    f32x2 a[4], b[4];
#pragma unroll
    for (int k = 0; k < 4; ++k) { a[k] = x[k] + x[k + 4]; b[k] = x[k] - x[k + 4]; }
    if (!INV) {
        b[1] = (f32x2){(b[1].x + b[1].y) * R, (b[1].y - b[1].x) * R};
        b[2] = (f32x2){b[2].y, -b[2].x};
        b[3] = (f32x2){(-b[3].x + b[3].y) * R, (-b[3].x - b[3].y) * R};
    } else {
        b[1] = (f32x2){(b[1].x - b[1].y) * R, (b[1].x + b[1].y) * R};
        b[2] = (f32x2){-b[2].y, b[2].x};
        b[3] = (f32x2){(-b[3].x - b[3].y) * R, (b[3].x - b[3].y) * R};
    }
    {
        f32x2 e0 = a[0] + a[2], e1 = a[0] - a[2], f0 = a[1] + a[3], d = a[1] - a[3];
        f32x2 f1 = INV ? (f32x2){-d.y, d.x} : (f32x2){d.y, -d.x};
        x[0] = e0 + f0; x[2] = e1 + f1; x[4] = e0 - f0; x[6] = e1 - f1;
    }
    {
        f32x2 e0 = b[0] + b[2], e1 = b[0] - b[2], f0 = b[1] + b[3], d = b[1] - b[3];
        f32x2 f1 = INV ? (f32x2){-d.y, d.x} : (f32x2){d.y, -d.x};
        x[1] = e0 + f0; x[3] = e1 + f1; x[5] = e0 - f0; x[7] = e1 - f1;
    }
}
template <int S> __device__ __forceinline__ const LAS f32x2* fft_wp(const LAS f32x2* tw, int j) { return S == 0 ? tw + j : (S == 1 ? tw + 3584 + j : tw + 4032 + j); }
template <int S> __device__ __forceinline__ void fft_stage_fwd(LAS f32x2* buf, const LAS f32x2* tw, int tid) {
    constexpr int q = 512 >> (3 * S), n = 8 * q;
    const int blk = tid / q, j = tid % q, base = blk * n + j;
    f32x2 x[8];
#pragma unroll
    for (int k = 0; k < 8; ++k) x[k] = buf[fpad(base + k * q)];
    dft8<false>(x);
    if (S < 3) { const LAS f32x2* wp = fft_wp<S>(tw, j);
#pragma unroll
        for (int m = 1; m < 8; ++m) x[m] = cmul(x[m], wp[(m - 1) * q]); }
#pragma unroll
    for (int k = 0; k < 8; ++k) buf[fpad(base + k * q)] = x[k];
}
template <int S> __device__ __forceinline__ void fft_stage_inv(LAS f32x2* buf, const LAS f32x2* tw, int tid) {
    constexpr int q = 512 >> (3 * S), n = 8 * q;
    const int blk = tid / q, j = tid % q, base = blk * n + j;
    f32x2 x[8];
#pragma unroll
    for (int k = 0; k < 8; ++k) x[k] = buf[fpad(base + k * q)];
    if (S < 3) { const LAS f32x2* wp = fft_wp<S>(tw, j);
#pragma unroll
        for (int m = 1; m < 8; ++m) x[m] = cmulc(x[m], wp[(m - 1) * q]); }
    dft8<true>(x);
#pragma unroll
    for (int k = 0; k < 8; ++k) buf[fpad(base + k * q)] = x[k];
}
__device__ __forceinline__ void fft_fwd(LAS f32x2* buf, const LAS f32x2* tw, int tid) {
    fft_stage_fwd<0>(buf, tw, tid); __syncthreads();
    fft_stage_fwd<1>(buf, tw, tid); __syncthreads();
    fft_stage_fwd<2>(buf, tw, tid); __syncthreads();
    fft_stage_fwd<3>(buf, tw, tid); __syncthreads();
}
__device__ __forceinline__ void fft_inv(LAS f32x2* buf, const LAS f32x2* tw, int tid) {
    fft_stage_inv<3>(buf, tw, tid); __syncthreads();
    fft_stage_inv<2>(buf, tw, tid); __syncthreads();
    fft_stage_inv<1>(buf, tw, tid); __syncthreads();
    fft_stage_inv<0>(buf, tw, tid); __syncthreads();
}
__device__ __forceinline__ void fft_fwd2(LAS f32x2* b0, LAS f32x2* b1, const LAS f32x2* tw, int tid) {
    fft_stage_fwd<0>(b0, tw, tid); fft_stage_fwd<0>(b1, tw, tid); __syncthreads();
    fft_stage_fwd<1>(b0, tw, tid); fft_stage_fwd<1>(b1, tw, tid); __syncthreads();
    fft_stage_fwd<2>(b0, tw, tid); fft_stage_fwd<2>(b1, tw, tid); __syncthreads();
    fft_stage_fwd<3>(b0, tw, tid); fft_stage_fwd<3>(b1, tw, tid); __syncthreads();
}
__device__ __forceinline__ void fft_inv2(LAS f32x2* b0, LAS f32x2* b1, const LAS f32x2* tw, int tid) {
    fft_stage_inv<3>(b0, tw, tid); fft_stage_inv<3>(b1, tw, tid); __syncthreads();
    fft_stage_inv<2>(b0, tw, tid); fft_stage_inv<2>(b1, tw, tid); __syncthreads();
    fft_stage_inv<1>(b0, tw, tid); fft_stage_inv<1>(b1, tw, tid); __syncthreads();
    fft_stage_inv<0>(b0, tw, tid); fft_stage_inv<0>(b1, tw, tid); __syncthreads();
}
__device__ __forceinline__ int digrev(int f) { return ((f & 7) << 9) | (((f >> 3) & 7) << 6) | (((f >> 6) & 7) << 3) | ((f >> 9) & 7); }
constexpr int FFT_BUF_OFF = 0, FFT_BUF1_OFF = 36864, FFT_TW_OFF = 73728, FFT_STAGE_OFF = 106496;
__device__ __forceinline__ void fft_init_tw(const Args& A, Frame& F) {
    LAS f32x2* tw = (LAS f32x2*)(F.lds + FFT_TW_OFF);
    for (int k = F.tid; k < 4088; k += NTHR) { int jm; float sc;
        if (k < 3584) { jm = (k & 511) * ((k >> 9) + 1); sc = 1.0f / 2048.0f; } else if (k < 4032) { const int r = k - 3584; jm = (r & 63) * ((r >> 6) + 1); sc = 1.0f / 256.0f; } else { const int r = k - 4032; jm = (r & 7) * ((r >> 3) + 1); sc = 1.0f / 32.0f; }
        float s, c; sincospif((float)jm * sc, &s, &c); tw[k] = (f32x2){c, -s}; }
    __syncthreads();
}

__device__ __forceinline__ void phase_p0(const Args& A, Frame& F) {
    unsigned char* wsl = A.ws; asm volatile("" : "+s"(wsl));
    const float* x = A.in[0]; float* ss = (float*)(wsl + WS_STAT); bf16* xb = (bf16*)(wsl + WS_XB);
    const int gw = F.vcu * NWAVES + F.wave, NGW = F.G * NWAVES;
    for (int row = gw; row < TOK; row += NGW) {
        const f32x4* xr = (const f32x4*)(x + (size_t)row * DM) + F.lane;
        u32x2* brow = (u32x2*)(xb + (size_t)row * DM) + F.lane;
        float s = 0.f;
#pragma unroll
        for (int j = 0; j < 4; ++j) { const f32x4 v = xr[64 * j]; s += (v.x * v.x + v.y * v.y) + (v.z * v.z + v.w * v.w); brow[64 * j] = (u32x2){cvtpk(v.x, v.y), cvtpk(v.z, v.w)}; }
        s = wave_sum(s, F.lane);
        if (F.lane == 0) ss[row] = s;
    }
    float* rc = (float*)(wsl + WS_ROPE);
    for (int i = F.vcu * NTHR + F.tid; i < SEQ * 16; i += F.G * NTHR) { const float invf = exp2f(-(float)(i & 15) * (13.287712379549449f / 16.0f)); float sn, cs; sincosf((float)(i >> 4) * invf, &sn, &cs); rc[i] = cs; rc[SEQ * 16 + i] = sn; }
}

__device__ __forceinline__ void tr_item(const float* W, int ldw, const float* g, float cs, bf16* WT, int ldt, int k0, int sn0, int dn0, LAS float* scr, int lane) {
#pragma unroll 8
    for (int i = 0; i < 32; ++i) { const int kk = 2 * i + (lane >> 5); const float gv = g ? g[k0 + kk] * cs : cs;
        scr[kk * 33 + (lane & 31)] = W[(size_t)(k0 + kk) * ldw + sn0 + (lane & 31)] * gv; }
    LDS_WAIT(); asm volatile("" ::: "memory");
    const int c = lane & 7;
#pragma unroll
    for (int j = 0; j < 4; ++j) { const int n = (lane >> 3) + 8 * j; const LAS float* s = scr + (8 * c) * 33 + n;
        v4u o; o.x = cvtpk(s[0 * 33], s[1 * 33]); o.y = cvtpk(s[2 * 33], s[3 * 33]); o.z = cvtpk(s[4 * 33], s[5 * 33]); o.w = cvtpk(s[6 * 33], s[7 * 33]);
        *(v4u*)(WT + (size_t)(dn0 + n) * ldt + k0 + 8 * c) = o; }
    LDS_WAIT(); asm volatile("" ::: "memory");
}
__device__ __forceinline__ void tr_item64(const float* W, int ldw, const float* g, bf16* WT, int ldt, int k0, int sn0, int dn0, LAS unsigned char* scr, int lane) {
    const int r2 = lane >> 4, c = lane & 15;
    const float* wp = W + (size_t)(k0 + 2 * r2) * ldw + sn0 + 4 * c;
    f32x4 v0[8], v1[8];
#pragma unroll
    for (int i = 0; i < 8; ++i) { v0[i] = *(const f32x4*)(wp + (size_t)(8 * i) * ldw); v1[i] = *(const f32x4*)(wp + (size_t)(8 * i + 1) * ldw); }
#pragma unroll
    for (int i = 0; i < 8; ++i) { const int k = 8 * i + 2 * r2; float g0 = 1.f, g1 = 1.f; if (g) { g0 = g[k0 + k]; g1 = g[k0 + k + 1]; }
#pragma unroll
        for (int j = 0; j < 4; ++j) { const int n = 4 * c + j;
            *(LAS unsigned*)(scr + n * 128 + (((k >> 3) ^ (c & 7)) << 4) + (k & 7) * 2) = cvtpk(v0[i][j] * g0, v1[i][j] * g1); } }
    LDS_WAIT(); asm volatile("" ::: "memory");
    const int ch = lane & 7;
#pragma unroll
    for (int jj = 0; jj < 8; ++jj) { const int n = (lane >> 3) + 8 * jj;
        const v4u o = *(const LAS v4u*)(scr + n * 128 + ((ch ^ ((n >> 2) & 7)) << 4));
        *(v4u*)(WT + (size_t)(dn0 + n) * ldt + k0 + 8 * ch) = o; }
    LDS_WAIT(); asm volatile("" ::: "memory");
}
__device__ __forceinline__ void tr_item_wg(const float* W, int ldw, const float* g, bf16* WT, int ldt, int k0, int sn0, int dnA, int dnB, LAS unsigned char* lds, int tid) {
    const int c = tid & 63, r = tid >> 6;
    const float* wp = W + (size_t)(k0 + 2 * r) * ldw + sn0 + 4 * c;
    f32x4 v0[8], v1[8];
#pragma unroll
    for (int i = 0; i < 8; ++i) { v0[i] = *(const f32x4*)(wp + (size_t)(16 * i) * ldw); v1[i] = *(const f32x4*)(wp + (size_t)(16 * i + 1) * ldw); }
#pragma unroll
    for (int i = 0; i < 8; ++i) { const int k = 16 * i + 2 * r; float g0 = 1.f, g1 = 1.f; if (g) { g0 = g[k0 + k]; g1 = g[k0 + k + 1]; }
#pragma unroll
        for (int j = 0; j < 4; ++j) *(LAS unsigned*)(lds + (4 * c + j) * 256 + (((k >> 3) ^ (c & 15)) << 4) + (k & 7) * 2) = cvtpk(v0[i][j] * g0, v1[i][j] * g1); }
    __syncthreads();
    const int ch = tid & 15;
#pragma unroll
    for (int jj = 0; jj < 8; ++jj) { const int n = (tid >> 4) + 32 * jj;
        const v4u o = *(const LAS v4u*)(lds + n * 256 + ((ch ^ ((n >> 2) & 15)) << 4));
        *(v4u*)(WT + (size_t)(n < 128 ? dnA + n : dnB + n - 128) * ldt + k0 + 8 * ch) = o; }
    __syncthreads();
}
__device__ __forceinline__ void fn_fold_item(const float* W, const float* g1, bf16* WT, int k0, int grp, LAS float* scr, int lane) {
    LAS float* tab = scr + 8 * 64;
    { float s, co; sincospif((float)lane * (1.0f / 32.0f), &s, &co); tab[lane] = co; }
#pragma unroll
    for (int i = 0; i < 8; ++i) scr[i * 64 + lane] = W[(size_t)(k0 + i) * IN_COLS + 768 + 64 * grp + lane] * g1[k0 + i];
    LDS_WAIT(); asm volatile("" ::: "memory");
    const int j = lane, m = j <= 32 ? j : j - 32; const float sc = (j <= 32 ? 1.0f : -1.0f) / 362.03867196751236f;
    const int sh = j <= 32 ? 0 : 48;
    float a[8];
#pragma unroll
    for (int q = 0; q < 8; ++q) a[q] = 0.f;
#pragma unroll 4
    for (int c = 0; c < 64; c += 4) { float d[4];
#pragma unroll
        for (int e = 0; e < 4; ++e) d[e] = tab[(m * (c + e) + sh) & 63];
#pragma unroll
        for (int q = 0; q < 8; ++q) { const f32x4 sv = *(const LAS f32x4*)(scr + q * 64 + c); a[q] += (sv.x * d[0] + sv.y * d[1]) + (sv.z * d[2] + sv.w * d[3]); } }
    v4u o; o.x = cvtpk(a[0] * sc, a[1] * sc); o.y = cvtpk(a[2] * sc, a[3] * sc); o.z = cvtpk(a[4] * sc, a[5] * sc); o.w = cvtpk(a[6] * sc, a[7] * sc);
    *(v4u*)(WT + (size_t)(768 + 64 * grp + j) * DM + k0) = o;
    LDS_WAIT(); asm volatile("" ::: "memory");
}
__device__ __forceinline__ void phase_l0a(const Args& A, Frame& F, int li) {
    unsigned char* wsl = A.ws; asm volatile("" : "+s"(wsl));
    LAS float* scr = (LAS float*)(F.lds + F.wave * 16384);
    const int NGW = F.G * NWAVES;
    const float* w_in = A.in[3] + (size_t)li * DM * IN_COLS; const float* g1 = A.in[2] + li * DM;
    const float* w_uq = A.in[15] + (size_t)li * 256 * 384; const float* qg = A.in[14] + li * 256;
    const float* w_ukv = A.in[17] + (size_t)li * 128 * 512; const float* kvg = A.in[16] + li * 128;
    const float* w_br = A.in[19] + (size_t)li * 4 * 256 * DM; const float* w_out = A.in[20] + (size_t)li * DM * DM;
    const float* g2 = A.in[21] + li * DM; const float* w_eg = A.in[23] + (size_t)li * NEXP * DM * DM; const float* w_eu = A.in[24] + (size_t)li * NEXP * DM * DM;
    const float* w_ed = A.in[25] + (size_t)li * NEXP * DM * DM; const float* g3 = A.in[26] + li * DM;
    const float* w_pg = A.in[27] + (size_t)li * DM * DM; const float* w_pp = A.in[28] + (size_t)li * 256 * DM;
    bf16* WIN = (bf16*)(wsl + WS_WIN); bf16* WUQ = (bf16*)(wsl + WS_WUQ); bf16* WUKV = (bf16*)(wsl + WS_WUKV); bf16* WBR = (bf16*)(wsl + WS_WBR);
    bf16* WOUT = (bf16*)(wsl + WS_WOUT); bf16* WPG = (bf16*)(wsl + WS_WPG); bf16* WPP = (bf16*)(wsl + WS_WPP); bf16* WE1 = (bf16*)(wsl + WS_WE1); bf16* WE2 = (bf16*)(wsl + WS_WE2);
    constexpr int W_E = 32, NWG_ITEMS = (NEXP * 3 + 2) * W_E;
    const int sub_ = A.sub;
    for (int stg_ = 0; stg_ < 2; ++stg_) {
    const int stage = (blockIdx.x & 1) ? 1 - stg_ : stg_;
    { int l_; asm volatile("v_mbcnt_lo_u32_b32 %0, -1, 0\n\tv_mbcnt_hi_u32_b32 %0, -1, %0" : "=v"(l_)); l_ &= 63; F.lane = l_; F.tid = F.wave * 64 + l_; }
    const int gw = F.vcu * NWAVES + F.wave, lane = F.lane;
    if (stage == 0 && (sub_ == 0 || sub_ == 1))
    for (int it = blockIdx.x; it < NWG_ITEMS; it += F.G) {
        const int mat = it / W_E, q = it % W_E, kb = q >> 2, nb = q & 3, f0 = 256 * nb;
        if (mat < NEXP * 2) { const int e = mat >> 1, up = mat & 1; const int dnA = 256 * (f0 >> 7) + 128 * up;
            tr_item_wg((up ? w_eu : w_eg) + (size_t)e * DM * DM, DM, g2, WE1 + (size_t)e * 2048 * DM, DM, 128 * kb, f0, dnA, dnA + 256, F.lds, F.tid); }
        else if (mat < NEXP * 3) { const int e = mat - NEXP * 2; tr_item_wg(w_ed + (size_t)e * DM * DM, DM, nullptr, WE2 + (size_t)e * DM * DM, DM, 128 * kb, f0, f0, f0 + 128, F.lds, F.tid); }
        else if (mat == NEXP * 3) tr_item_wg(w_out, DM, nullptr, WOUT, DM, 128 * kb, f0, f0, f0 + 128, F.lds, F.tid);
        else tr_item_wg(w_pg, DM, g3, WPG, DM, 128 * kb, f0, f0, f0 + 128, F.lds, F.tid);
    }
    constexpr int I_IN = 16 * 99, I_UQ = 4 * 12, I_UKV = 2 * 16, I_BR = 4 * 4 * 16, I_PP = 4 * 16, I_FN = 512;
    constexpr int NITEMS = I_IN + I_UQ + I_UKV + I_BR + I_PP + I_FN;
    LAS unsigned char* scr8 = (LAS unsigned char*)scr;
    if (stage == 1) {
    if (sub_ == 0 || sub_ == 2)
    for (int it = gw; it < NITEMS; it += NGW) {
        int r = it;
        if (r < I_IN) { const int kb = r / 99, nb = r % 99;
            if (nb < 12) tr_item64(w_in, IN_COLS, g1, WIN, DM, 64 * kb, 64 * nb, 64 * nb, scr8, lane);
            else if (nb < 18) tr_item64(w_in, IN_COLS, g1, WIN, DM, 64 * kb, 1024 + 64 * (nb - 12), 1024 + 64 * (nb - 12), scr8, lane);
            else if (nb == 18) tr_item(w_in, IN_COLS, g1, 1.f, WIN, DM, 64 * kb, 1408, 1408, scr, lane);
            else if (nb < 31) tr_item64(w_in, IN_COLS, g1, WIN, DM, 64 * kb, 1440 + 64 * (nb - 19), 1536 + 64 * (nb - 19), scr8, lane);
            else if (nb < 95) tr_item64(w_in, IN_COLS, g1, WIN, DM, 64 * kb, 2208 + 64 * (nb - 31), 2304 + 64 * (nb - 31), scr8, lane);
            continue; }
        r -= I_IN;
        if (r < I_UQ) { const int kb = r / 12, nb = r % 12; tr_item(w_uq, 384, qg, 0.10206207261596577f * LOG2E, WUQ, 256, 64 * kb, 32 * nb, 32 * nb, scr, lane); continue; }
        r -= I_UQ;
        if (r < I_UKV) { const int kb = r / 16, nb = r % 16; tr_item(w_ukv, 512, kvg, 1.f, WUKV, 256, 64 * kb, 32 * nb, 32 * nb, scr, lane); continue; }
        r -= I_UKV;
        if (r < I_BR) { const int n = r / 64, q2 = r % 64, kb = q2 / 16, nb = q2 % 16; tr_item64(w_br + (size_t)n * 256 * DM, DM, nullptr, WBR + (size_t)n * DM * 256, 256, 64 * kb, 64 * nb, 64 * nb, scr8, lane); continue; }
        r -= I_BR;
        if (r < I_PP) { const int kb = r / 16, nb = r % 16; tr_item64(w_pp, DM, nullptr, WPP, 256, 64 * kb, 64 * nb, 64 * nb, scr8, lane); continue; }
        r -= I_PP;
        fn_fold_item(w_in, g1, WIN, 8 * (r >> 2), r & 3, scr, lane);
    }
    if (sub_ == 0 || sub_ == 3) {
    const int gt = F.vcu * NTHR + F.tid, NGT = F.G * NTHR;
    unsigned zz_ = 0u; asm volatile("" : "+v"(zz_)); const v4u z4 = (v4u){zz_, zz_, zz_, zz_};
    for (int i = gt; i < 96 * 1024 / 8; i += NGT) ((v4u*)(WIN + (size_t)1440 * DM))[i] = z4;
    for (int i = gt; i < 128 * 256 / 8; i += NGT) ((v4u*)(WUQ + (size_t)384 * 256))[i] = z4;
    for (int i = gt; i < 512 * 16; i += NGT) ((v4u*)(WUKV + (size_t)(i >> 4) * 256 + 128))[i & 15] = z4;
    float* st = (float*)(wsl + WS_STAT);
    if (li > 0) { const f32x4* sp = (const f32x4*)(wsl + WS_SSP);
        for (int i = gt; i < TOK; i += NGT) { const f32x4 p0 = sp[4 * i], p1 = sp[4 * i + 1], p2 = sp[4 * i + 2], p3 = sp[4 * i + 3];
            st[(size_t)li * TOK + i] = (((p0.x + p0.y) + (p0.z + p0.w)) + ((p1.x + p1.y) + (p1.z + p1.w))) + (((p2.x + p2.y) + (p2.z + p2.w)) + ((p3.x + p3.y) + (p3.z + p3.w))); } }
    const f32x4* p4 = (const f32x4*)(A.in[1] + (size_t)li * TOK * 256); u32x2* pb = (u32x2*)(wsl + WS_PB);
    for (int i = gt; i < TOK * 256 / 4; i += NGT) { const f32x4 v = p4[i]; pb[i] = (u32x2){cvtpk(v.x, v.y), cvtpk(v.z, v.w)}; }
    }
    __syncthreads();
    if (sub_ == 0 || sub_ == 4) {
        LAS float* zs = (LAS float*)F.lds; LAS float* h1s = zs + 8 * 36; LAS float* h2s = h1s + 8 * 64;
        const float* w1 = A.in[7] + li * 33 * 64; const float* b1 = A.in[8] + li * 64; const float* fr = A.in[9] + li * 128;
        const float* w2 = A.in[10] + li * 64 * 64; const float* b2 = A.in[11] + li * 64; const float* w3 = A.in[12] + (size_t)li * 64 * 1024;
        float* KT = (float*)(wsl + WS_KT);
        const int tid = F.tid;
        for (int u = blockIdx.x; u < 256; u += F.G) {
            const int l0 = 8 * u;
            if (tid < 8 * 33) { const int p = tid / 33, i = tid % 33, l = l0 + p; float v;
                if (i == 0) v = (float)l / 2047.0f;
                else { const int b = (i - 1) & 15; const float band = 1e-4f + (float)b * ((15.0f - 1e-4f) / 15.0f); const float ang = ((6.283185307179586f * (float)l) * band) / 2048.0f;
                    float s, c; sincosf(ang, &s, &c); v = (i <= 16) ? c : -s; }
                zs[p * 36 + i] = v; }
            __syncthreads();
            { const int p = tid >> 6, j = tid & 63; float a = b1[j];
#pragma unroll
                for (int i = 0; i < 33; ++i) a += zs[p * 36 + i] * w1[i * 64 + j];
                h1s[p * 64 + j] = sinf(fr[j] * a); }
            __syncthreads();
            { const int p = tid >> 6, j = tid & 63; float a = b2[j];
#pragma unroll 16
                for (int i = 0; i < 64; ++i) a += h1s[p * 64 + i] * w2[i * 64 + j];
                h2s[p * 64 + j] = sinf(fr[64 + j] * a); }
            __syncthreads();
#pragma unroll
            for (int cc = 0; cc < 2; ++cc) { const int col = tid + 512 * cc; float a[8];
#pragma unroll
                for (int p = 0; p < 8; ++p) a[p] = 0.f;
#pragma unroll 4
                for (int i = 0; i < 64; i += 4) { const float w0 = w3[i * 1024 + col], w1_ = w3[(i + 1) * 1024 + col], w2_ = w3[(i + 2) * 1024 + col], w3_ = w3[(i + 3) * 1024 + col];
#pragma unroll
                    for (int p = 0; p < 8; ++p) { const f32x4 hv = *(const LAS f32x4*)(h2s + p * 64 + i); a[p] += (hv.x * w0 + hv.y * w1_) + (hv.z * w2_ + hv.w * w3_); } }
                const int o = col >> 9, dir = (col >> 8) & 1, c = col & 255;
                const float mind = -3.0701134573253945f, maxd = -15.350567286626973f;
                const float ad = fabsf(mind + (float)c * ((maxd - mind) / 255.0f));
                float* kt = KT + (size_t)(o * 256 + c) * 4096;
#pragma unroll
                for (int p = 0; p < 8; ++p) { const int l = l0 + p; const float wv = a[p] * __expf(-((float)l / 2047.0f) * ad);
                    if (dir == 0) kt[l] = wv; else if (l > 0) kt[4096 - l] = wv; }
                if (u == 0 && dir == 0) kt[2048] = 0.f; }
            __syncthreads();
        }
    }
    }
    __syncthreads();
    }
}
__device__ __forceinline__ void filter_fft(const Args& A, Frame& F, int cc, int GG) {
    unsigned char* wsl = A.ws; asm volatile("" : "+s"(wsl));
    LAS f32x2* buf = (LAS f32x2*)(F.lds + FFT_BUF_OFF); const LAS f32x2* tw = (const LAS f32x2*)(F.lds + FFT_TW_OFF); LAS float* red = (LAS float*)(F.lds + FFT_STAGE_OFF);
    const float* KT = (const float*)(wsl + WS_KT); f32x2* KF = (f32x2*)(wsl + WS_KF);
    fft_init_tw(A, F);
    for (int u = cc; u < 512; u += GG) {
        const float* kt = KT + (size_t)u * 4096; float v[8]; float s = 0.f;
#pragma unroll
        for (int k = 0; k < 8; ++k) { v[k] = kt[F.tid + 512 * k]; s += v[k] * v[k]; }
        s = wave_sum(s, F.lane);
        if (F.lane == 0) red[F.wave] = s;
        __syncthreads();
        float tot = 0.f;
#pragma unroll
        for (int w = 0; w < 8; ++w) tot += red[w];
        const float sc = rsqrtf(tot + EPS) * (1.0f / 4096.0f);
#pragma unroll
        for (int k = 0; k < 8; ++k) buf[fpad(F.tid + 512 * k)] = (f32x2){v[k] * sc, 0.f};
        __syncthreads();
        fft_fwd(buf, tw, F.tid);
#pragma unroll
        for (int k = 0; k < 8; ++k) KF[(size_t)u * 4096 + F.tid + 512 * k] = buf[fpad(F.tid + 512 * k)];
        __syncthreads();
    }
}
#ifndef MK_DROP
#define MK_DROP 0
#endif

typedef const f32x4 (&AccRef)[2][2][4][2];
__device__ __forceinline__ void st_bf16x4(bf16* p, f32x4 v) { *(u32x2*)p = (u32x2){cvtpk(v.x, v.y), cvtpk(v.z, v.w)}; }
__device__ __forceinline__ f32x4 ld_bf16x4(const bf16* p) { const u32x2 w = *(const u32x2*)p;
    return (f32x4){__builtin_bit_cast(float, w.x << 16), __builtin_bit_cast(float, w.x & 0xffff0000u), __builtin_bit_cast(float, w.y << 16), __builtin_bit_cast(float, w.y & 0xffff0000u)}; }

__device__ __forceinline__ unsigned llt_lane(int wr, int wc, int fr, int fq) { return (unsigned)(((wr * 4 + wc) * 64 + fq * 16 + fr) * 4); }
__device__ __forceinline__ unsigned llt_q(int ai, int bj, int m, int n) { return (unsigned)((((ai * 2 + bj) * 4 + m) * 2 + n) * 2048); }
struct EpiWin {
    static constexpr bool PERM = false, AFTER_DRAIN = false, HALFN = false;
    const float* ss1; const float* bgate; unsigned char* ws;
    __device__ __forceinline__ void operator()(AccRef acc, const pg8::Unit& u, int wr, int wc, int fr, int fq) const {
        asm volatile("" : "+v"(fr), "+v"(fq));
        const int pn = u.pn, row0 = u.pm * 256 + wr * 64 + fr;
        float rs[2][4];
#pragma unroll
        for (int ai = 0; ai < 2; ++ai)
#pragma unroll
            for (int m = 0; m < 4; ++m) rs[ai][m] = rsqrtf(ss1[row0 + ai * 128 + m * 16] * (1.0f / 1024.0f) + EPS);
        if (pn >= 9) {
            unsigned char* G = (unsigned char*)(ws + WS_GATES) + (size_t)(u.pm * 16 + (pn - 9)) * 65536; const int cg0 = 256 * (pn - 9) + 32 * wc + 4 * fq; const unsigned ll = llt_lane(wr, wc, fr, fq);
#pragma unroll
            for (int bj = 0; bj < 2; ++bj)
#pragma unroll
                for (int n = 0; n < 2; ++n) { const int cg = cg0 + 128 * bj + 16 * n; const f32x4 bv = *(const f32x4*)(bgate + cg); unsigned lo = ll; asm volatile("" : "+v"(lo));
#pragma unroll
                    for (int ai = 0; ai < 2; ++ai)
#pragma unroll
                        for (int m = 0; m < 4; ++m) { const f32x4 a = acc[ai][bj][m][n] * rs[ai][m] + bv;
                            const unsigned q0 = (unsigned)(sigmoidf_(a.x) * 255.0f + 0.5f), q1 = (unsigned)(sigmoidf_(a.y) * 255.0f + 0.5f), q2 = (unsigned)(sigmoidf_(a.z) * 255.0f + 0.5f), q3 = (unsigned)(sigmoidf_(a.w) * 255.0f + 0.5f);
                            *(unsigned*)(G + (lo + llt_q(ai, bj, m, n))) = q0 | (q1 << 8) | (q2 << 16) | (q3 << 24); } }
        } else if (pn <= 3 || pn == 8) {
            bf16* D; int NC, ct0;
            if (pn <= 2) { D = (bf16*)(ws + WS_UHYT); NC = 768; ct0 = 256 * pn; } else if (pn == 3) { D = (bf16*)(ws + WS_UFNT); NC = 256; ct0 = 0; } else { D = (bf16*)(ws + WS_NAVT); NC = 256; ct0 = 0; }
            const int b = row0 >> 11, l0 = row0 & 2047;
#pragma unroll
            for (int bj = 0; bj < 2; ++bj)
#pragma unroll
                for (int n = 0; n < 2; ++n) { const int ct = ct0 + 128 * bj + 32 * wc + 16 * n + 4 * fq; bf16* dp = D + ((size_t)(b * NC + ct)) * 2048 + l0;
#pragma unroll
                    for (int ai = 0; ai < 2; ++ai)
#pragma unroll
                        for (int m = 0; m < 4; ++m) { const f32x4 a = acc[ai][bj][m][n] * rs[ai][m]; bf16* q = dp + ai * 128 + m * 16;
                            const unsigned w0 = cvtpk(a.x, a.y), w1 = cvtpk(a.z, a.w);
                            q[0] = (bf16)w0; q[2048] = (bf16)(w0 >> 16); q[4096] = (bf16)w1; q[6144] = (bf16)(w1 >> 16); } }
        } else {
            bf16* D = (bf16*)(ws + (pn == 4 ? WS_CQ : pn == 5 ? WS_CKV : pn == 6 ? WS_NAQ : WS_NAK));
            const float csc = (pn == 6) ? 0.125f * LOG2E : 1.0f;
            float* ssx = (float*)(ws + WS_STAT) + (size_t)(pn == 4 ? 7 : 11) * TOK;
#pragma unroll
            for (int ai = 0; ai < 2; ++ai)
#pragma unroll
                for (int m = 0; m < 4; ++m) { const int row = row0 + ai * 128 + m * 16; float s = 0.f;
#pragma unroll
                    for (int bj = 0; bj < 2; ++bj)
#pragma unroll
                        for (int n = 0; n < 2; ++n) { const f32x4 a = acc[ai][bj][m][n] * (rs[ai][m] * csc);
                            st_bf16x4(D + (size_t)row * 256 + 128 * bj + 32 * wc + 16 * n + 4 * fq, a);
                            if (pn == 4 || (pn == 5 && bj == 0)) s += (a.x * a.x + a.y * a.y) + (a.z * a.z + a.w * a.w); }
                    if (pn == 4 || pn == 5) { s += shx(s, 16, fq * 16 + fr); s += shx(s, 32, fq * 16 + fr); if (fq == 0) ssx[(size_t)row * 4 + wc] = s; }
                    if (pn == 5 && wc == 0) {
                        const f32x4 x1 = acc[ai][1][m][0] * rs[ai][m], x2 = acc[ai][1][m][1] * rs[ai][m]; const float* rc = (const float*)(ws + WS_ROPE) + (row & 2047) * 16 + 4 * fq;
                        const f32x4 cs = *(const f32x4*)rc, sn = *(const f32x4*)(rc + SEQ * 16); const f32x4 o1 = x1 * cs - x2 * sn, o2 = x2 * cs + x1 * sn;
                        bf16* kf = (bf16*)(ws + WS_KFULL) + (size_t)row * 384 + 64 + 4 * fq;
#pragma unroll
                        for (int h = 0; h < 4; ++h) { st_bf16x4(kf + h * 96, o1); st_bf16x4(kf + h * 96 + 16, o2); }
                    } }
        }
    }
};
struct EpiQ {
    static constexpr bool PERM = false, AFTER_DRAIN = false, HALFN = false;
    unsigned char* ws;
    __device__ __forceinline__ void operator()(AccRef acc, const pg8::Unit& u, int wr, int wc, int fr, int fq) const {
        const float* ssq = (const float*)(ws + WS_STAT) + (size_t)7 * TOK; bf16* Q = (bf16*)(ws + WS_Q);
        const int row0 = u.pm * 256 + wr * 64 + fr;
        float rq[2][4];
#pragma unroll
        for (int ai = 0; ai < 2; ++ai)
#pragma unroll
            for (int m = 0; m < 4; ++m) { const f32x4 pq = *(const f32x4*)(ssq + (size_t)(row0 + ai * 128 + m * 16) * 4); rq[ai][m] = rsqrtf(((pq.x + pq.y) + (pq.z + pq.w)) * (1.0f / 256.0f) + EPS); }
#pragma unroll
        for (int bj = 0; bj < 2; ++bj) { const int gb = 256 * u.pn + 128 * bj + 32 * wc; if (gb >= 384) continue; const bool rope = (gb % 96) == 64;
#pragma unroll
            for (int ai = 0; ai < 2; ++ai)
#pragma unroll
                for (int m = 0; m < 4; ++m) { const int row = row0 + ai * 128 + m * 16; const float r = rq[ai][m];
                    f32x4 o1 = acc[ai][bj][m][0] * r, o2 = acc[ai][bj][m][1] * r;
                    if (rope) { const f32x4 x1 = o1, x2 = o2; const float* rc = (const float*)(ws + WS_ROPE) + (row & 2047) * 16 + 4 * fq;
                        const f32x4 cs = *(const f32x4*)rc, sn = *(const f32x4*)(rc + SEQ * 16); o1 = x1 * cs - x2 * sn; o2 = x2 * cs + x1 * sn; }
                    st_bf16x4(Q + (size_t)row * 384 + gb + 4 * fq, o1); st_bf16x4(Q + (size_t)row * 384 + gb + 16 + 4 * fq, o2); if (m == 3) asm volatile("" ::: "memory"); } }
    }
};
struct EpiKV {
    static constexpr bool PERM = false, AFTER_DRAIN = false, HALFN = false;
    unsigned char* ws;
    __device__ __forceinline__ void operator()(AccRef acc, const pg8::Unit& u, int wr, int wc, int fr, int fq) const {
        const float* sskv = (const float*)(ws + WS_STAT) + (size_t)11 * TOK; bf16* KFU = (bf16*)(ws + WS_KFULL); bf16* VT = (bf16*)(ws + WS_VT);
        const int row0 = u.pm * 256 + wr * 64 + fr;
        float rq[2][4];
#pragma unroll
        for (int ai = 0; ai < 2; ++ai)
#pragma unroll
            for (int m = 0; m < 4; ++m) { const f32x4 pq = *(const f32x4*)(sskv + (size_t)(row0 + ai * 128 + m * 16) * 4); rq[ai][m] = rsqrtf(((pq.x + pq.y) + (pq.z + pq.w)) * (1.0f / 128.0f) + EPS); }
#pragma unroll
        for (int ai = 0; ai < 2; ++ai)
#pragma unroll
            for (int m = 0; m < 4; ++m) { const int row = row0 + ai * 128 + m * 16; const float r = rq[ai][m]; const int b = row >> 11, l = row & 2047;
#pragma unroll
                for (int bj = 0; bj < 2; ++bj) { const int h = 2 * u.pn + bj;
#pragma unroll
                    for (int n = 0; n < 2; ++n) { const f32x4 a = acc[ai][bj][m][n] * r; const int within = 32 * wc + 16 * n + 4 * fq;
                        if (wc < 2) st_bf16x4(KFU + (size_t)row * 384 + h * 96 + within, a);
                        else { bf16* q = VT + ((size_t)((b * 4 + h) * 64 + (within - 64))) * 2048 + l; const unsigned w0 = cvtpk(a.x, a.y), w1 = cvtpk(a.z, a.w);
                            q[0] = (bf16)w0; q[2048] = (bf16)(w0 >> 16); q[4096] = (bf16)w1; q[6144] = (bf16)(w1 >> 16); } } }
                asm volatile("" ::: "memory"); }
    }
};
struct EpiBranch {
    static constexpr bool PERM = false, AFTER_DRAIN = false, HALFN = true;
    unsigned char* ws;
    __device__ __forceinline__ void operator()(f32x4 (&acc)[2][2][4][2], const pg8::Unit& u, int wr, int wc, int fr, int fq) const {
        const int n = u.aux & 3, h = u.aux >> 2; const unsigned char* G = (const unsigned char*)(ws + WS_GATES) + (size_t)(u.pm * 16 + n * 4 + u.pn) * 65536; bf16* MG = (bf16*)(ws + WS_MERGED);
        const int row0 = u.pm * 256 + wr * 64 + fr, col0 = u.pn * 256 + 128 * h + 32 * wc + 4 * fq; const unsigned ll = llt_lane(wr, wc, fr, fq);
#pragma unroll
        for (int ai = 0; ai < 2; ++ai) { unsigned lo = ll; asm volatile("" : "+v"(lo));
            unsigned gv[4][2];
#pragma unroll
            for (int m = 0; m < 4; ++m)
#pragma unroll
                for (int nn = 0; nn < 2; ++nn) gv[m][nn] = *(const unsigned*)(G + (lo + llt_q(ai, h, m, nn)));
#pragma unroll
            for (int m = 0; m < 4; ++m)
#pragma unroll
                for (int nn = 0; nn < 2; ++nn) { const unsigned gw = gv[m][nn];
                    const f32x4 g = (f32x4){(float)(gw & 255u), (float)((gw >> 8) & 255u), (float)((gw >> 16) & 255u), (float)(gw >> 24)} * (1.0f / 255.0f);
                    f32x4 v = acc[ai][0][m][nn] * g;
                    if ((MK_DROP >> n) & 1) v = v * 0.f;
                    if (n > 0) v += acc[ai][1][m][nn];
                    if (n < 3) acc[ai][1][m][nn] = v; else st_bf16x4(MG + (size_t)(row0 + ai * 128 + m * 16) * DM + col0 + 16 * nn, v); } }
    }
};
struct EpiResid {
    static constexpr bool PERM = false, AFTER_DRAIN = false, HALFN = false;
    unsigned char* ws; int dry;
    __device__ __forceinline__ void operator()(AccRef acc, const pg8::Unit& u, int wr, int wc, int fr, int fq) const {
        bf16* XB = (bf16*)(ws + WS_XB);
        const int row0 = u.pm * 256 + wr * 64 + fr, col0 = u.pn * 256 + 32 * wc + 4 * fq;
#pragma unroll
        for (int ai = 0; ai < 2; ++ai) {
            u32x2 xv[4][2][2];
#pragma unroll
            for (int m = 0; m < 4; ++m)
#pragma unroll
                for (int bj = 0; bj < 2; ++bj)
#pragma unroll
                    for (int nn = 0; nn < 2; ++nn) xv[m][bj][nn] = *(const u32x2*)(XB + (size_t)(row0 + ai * 128 + m * 16) * DM + col0 + 128 * bj + 16 * nn);
#pragma unroll
            for (int m = 0; m < 4; ++m)
#pragma unroll
                for (int bj = 0; bj < 2; ++bj)
#pragma unroll
                    for (int nn = 0; nn < 2; ++nn) { const size_t o = (size_t)(row0 + ai * 128 + m * 16) * DM + col0 + 128 * bj + 16 * nn; const u32x2 w = xv[m][bj][nn];
                        const f32x4 v = (f32x4){__builtin_bit_cast(float, w.x << 16), __builtin_bit_cast(float, w.x & 0xffff0000u), __builtin_bit_cast(float, w.y << 16), __builtin_bit_cast(float, w.y & 0xffff0000u)} + acc[ai][bj][m][nn];
                        if (!dry) st_bf16x4(XB + o, v); else asm volatile("" :: "v"(v)); }
            asm volatile("" ::: "memory"); }
    }
};
struct EpiSwiglu {
    static constexpr bool PERM = false, AFTER_DRAIN = false, HALFN = false;
    unsigned char* ws;
    __device__ __forceinline__ void operator()(AccRef acc, const pg8::Unit& u, int wr, int wc, int fr, int fq) const {
        const float* rsc = (const float*)(ws + WS_SEL); bf16* HB = (bf16*)(ws + WS_HB);
        const int row0 = u.pm * 256 + wr * 64 + fr, col0 = (u.pn & 7) * 128 + 32 * wc + 4 * fq;
#pragma unroll
        for (int ai = 0; ai < 2; ++ai)
#pragma unroll
            for (int m = 0; m < 4; ++m) { const int row = row0 + ai * 128 + m * 16; const float r = rsc[row];
#pragma unroll
                for (int nn = 0; nn < 2; ++nn) { const f32x4 g = acc[ai][0][m][nn] * r, up = acc[ai][1][m][nn] * r; f32x4 h;
#pragma unroll
                    for (int j = 0; j < 4; ++j) h[j] = g[j] * sigmoidf_(g[j]) * up[j];
                    st_bf16x4(HB + (size_t)row * DM + col0 + 16 * nn, h); } }
    }
};
struct EpiDown {
    static constexpr bool PERM = false, AFTER_DRAIN = false, HALFN = false;
    unsigned char* ws;
    __device__ __forceinline__ void operator()(AccRef acc, const pg8::Unit& u, int wr, int wc, int fr, int fq) const {
        const float* aff = (const float*)(ws + WS_SEL) + NSLOT; bf16* YE = (bf16*)(ws + WS_XE);
        const int row0 = u.pm * 256 + wr * 64 + fr, col0 = (u.pn & 3) * 256 + 32 * wc + 4 * fq;
#pragma unroll
        for (int ai = 0; ai < 2; ++ai)
#pragma unroll
            for (int m = 0; m < 4; ++m) { const int row = row0 + ai * 128 + m * 16; const float r = 1.0f; (void)aff;
#pragma unroll
                for (int bj = 0; bj < 2; ++bj)
#pragma unroll
                    for (int nn = 0; nn < 2; ++nn) st_bf16x4(YE + (size_t)row * DM + col0 + 128 * bj + 16 * nn, acc[ai][bj][m][nn] * r); }
    }
};
struct EpiPP {
    static constexpr bool PERM = false, AFTER_DRAIN = false, HALFN = false;
    unsigned char* ws;
    __device__ __forceinline__ void operator()(AccRef acc, const pg8::Unit& u, int wr, int wc, int fr, int fq) const {
        bf16* PPt = (bf16*)(ws + WS_PP) + (size_t)(u.pm * 4 + u.pn) * 65536; const unsigned ll = llt_lane(wr, wc, fr, fq);
#pragma unroll
        for (int ai = 0; ai < 2; ++ai)
#pragma unroll
            for (int m = 0; m < 4; ++m) { unsigned lo = ll; asm volatile("" : "+v"(lo));
#pragma unroll
                for (int bj = 0; bj < 2; ++bj)
#pragma unroll
                    for (int nn = 0; nn < 2; ++nn) st_bf16x4(PPt + (lo + llt_q(ai, bj, m, nn)), acc[ai][bj][m][nn]); }
    }
};
struct EpiPle {
    static constexpr bool PERM = false, AFTER_DRAIN = false, HALFN = false;
    unsigned char* ws; float* ssn; int dry;
    __device__ __forceinline__ void operator()(AccRef acc, const pg8::Unit& u, int wr, int wc, int fr, int fq) const {
        const float* ir3 = (const float*)(ws + WS_STAT) + (size_t)6 * TOK; const bf16* PPt = (const bf16*)(ws + WS_PP) + (size_t)(u.pm * 4 + u.pn) * 65536; bf16* XB = (bf16*)(ws + WS_XB); const unsigned ll = llt_lane(wr, wc, fr, fq);
        const int row0 = u.pm * 256 + wr * 64 + fr, col0 = u.pn * 256 + 32 * wc + 4 * fq;
#pragma unroll
        for (int ai = 0; ai < 2; ++ai)
#pragma unroll
            for (int mp = 0; mp < 2; ++mp) {
                unsigned lo = ll; asm volatile("" : "+v"(lo));
                u32x2 xv[2][2][2], pw[2][2][2]; float rr[2];
#pragma unroll
                for (int mi = 0; mi < 2; ++mi) { const int m = 2 * mp + mi, row = row0 + ai * 128 + m * 16; rr[mi] = ir3[row];
#pragma unroll
                    for (int bj = 0; bj < 2; ++bj)
#pragma unroll
                        for (int nn = 0; nn < 2; ++nn) { xv[mi][bj][nn] = *(const u32x2*)(XB + (size_t)row * DM + col0 + 128 * bj + 16 * nn); pw[mi][bj][nn] = *(const u32x2*)(PPt + (lo + llt_q(ai, bj, m, nn))); } }
#pragma unroll
                for (int mi = 0; mi < 2; ++mi) { const int m = 2 * mp + mi, row = row0 + ai * 128 + m * 16; float s = 0.f;
#pragma unroll
                    for (int bj = 0; bj < 2; ++bj)
#pragma unroll
                        for (int nn = 0; nn < 2; ++nn) { const size_t o = (size_t)row * DM + col0 + 128 * bj + 16 * nn; const f32x4 a = acc[ai][bj][m][nn] * rr[mi]; const u32x2 w = pw[mi][bj][nn];
                            const f32x4 pp = (f32x4){__builtin_bit_cast(float, w.x << 16), __builtin_bit_cast(float, w.x & 0xffff0000u), __builtin_bit_cast(float, w.y << 16), __builtin_bit_cast(float, w.y & 0xffff0000u)};
                            const u32x2 xw = xv[mi][bj][nn]; f32x4 v = (f32x4){__builtin_bit_cast(float, xw.x << 16), __builtin_bit_cast(float, xw.x & 0xffff0000u), __builtin_bit_cast(float, xw.y << 16), __builtin_bit_cast(float, xw.y & 0xffff0000u)};
#pragma unroll
                            for (int j = 0; j < 4; ++j) v[j] += ((MK_DROP >> 5) & 1) ? 0.f : sigmoidf_(a[j]) * pp[j];
                            if (!dry) st_bf16x4(XB + o, v); s += (v.x * v.x + v.y * v.y) + (v.z * v.z + v.w * v.w); }
                    s += shx(s, 16, fq * 16 + fr); s += shx(s, 32, fq * 16 + fr); if (fq == 0) ssn[(size_t)row * 16 + u.pn * 4 + wc] = s; }
                asm volatile("" ::: "memory"); }
    }
};
struct MoeOrder {
    int G, c, npn, total;
    __device__ __forceinline__ bool next(int i, pg8::Unit& u) const {
        if (G != 256) { const int L = i * G + c; if (L >= total) return false; const int upe = 8 * npn, e = L / upe, rem = L % upe; u.pm = e * 8 + rem / npn; u.pn = e * npn + rem % npn; u.aux = 0; return true; }
        const int x = c & 7, k = c >> 3; int e, b, pn;
        if (npn == 8) { if (i >= 4) return false; e = 4 * i + (x >> 1); b = 4 * (x & 1) + (k >> 3); pn = k & 7; }
        else { if (i >= 2) return false; e = 8 * i + x; b = k >> 2; pn = k & 3; }
        u.pm = e * 8 + b; u.pn = e * npn + pn; u.aux = 0; return true;
    }
    __device__ __forceinline__ void ptrs(const pg8::Gemm& g, const pg8::Unit& u, size_t tstep, const char*& a, const char*& b) const { a = (const char*)g.A + (size_t)u.pm * tstep; b = (const char*)g.Bt + (size_t)u.pn * tstep; }
    __device__ __forceinline__ void a_ready(const pg8::Unit&) const {}
    __device__ __forceinline__ void done(const pg8::Unit&) const {}
};
struct BranchOrder {
    pg8::StaticOrder so;
    __device__ __forceinline__ bool next(int i, pg8::Unit& u) const { if (!so.next(i >> 3, u)) return false; u.aux = i & 7; return true; }
    __device__ __forceinline__ void ptrs(const pg8::Gemm& g, const pg8::Unit& u, size_t tstep, const char*& a, const char*& b) const {
        a = (const char*)g.A + (size_t)(u.aux & 3) * (8 * MiB) + (size_t)u.pm * tstep; b = (const char*)g.Bt + (size_t)(u.aux & 3) * (DM * 256 * 2) + (size_t)u.pn * tstep + (size_t)(u.aux >> 2) * (tstep >> 1); }
    __device__ __forceinline__ void a_ready(const pg8::Unit&) const {}
    __device__ __forceinline__ void done(const pg8::Unit&) const {}
};


__device__ __forceinline__ float hy_uc(const bf16* up, int l, float w0, float w1, float w2, float bb) {
    const float a = l > 0 ? bf2f(up[l - 1]) : 0.f, b = bf2f(up[l]), c = l < SEQ - 1 ? bf2f(up[l + 1]) : 0.f;
    return w0 * a + w1 * b + w2 * c + bb;
}
__device__ __forceinline__ void hyena_phase(const Args& A, Frame& F, int li) {
    unsigned char* wsl = A.ws; asm volatile("" : "+s"(wsl));
    LAS f32x2* bufA = (LAS f32x2*)(F.lds + FFT_BUF_OFF); LAS f32x2* bufB = (LAS f32x2*)(F.lds + FFT_BUF1_OFF); const LAS f32x2* tw = (const LAS f32x2*)(F.lds + FFT_TW_OFF); LAS bf16* stg = (LAS bf16*)(F.lds + FFT_STAGE_OFF);
    const bf16* U = (const bf16*)(wsl + WS_UHYT); const f32x2* KF = (const f32x2*)(wsl + WS_KF); bf16* Y = (bf16*)(wsl + WS_YHY);
    const float* cw = A.in[5] + li * 3 * 768; const float* cb = A.in[6] + li * 768; const float* skip = A.in[13] + li * 512;
    const int tid = F.tid; float zf = 0.f; asm volatile("" : "+v"(zf));
    for (int unit = blockIdx.x; unit < 256; unit += F.G) {
        const int bp = unit >> 6, c0 = (unit & 63) * 4, b0 = 2 * bp;
        for (int cp = 0; cp < 2; ++cp) {
            float v[2][2][4], x1[2][2][4], x2[2][2][4], z[2][2][4];
#pragma unroll
            for (int q = 0; q < 2; ++q) { const int c = c0 + 2 * cp + q;
                const float a0 = cw[c], a1 = cw[768 + c], a2 = cw[1536 + c], ab = cb[c];
                const float d0 = cw[256 + c], d1 = cw[768 + 256 + c], d2 = cw[1536 + 256 + c], db = cb[256 + c];
                const float e0 = cw[512 + c], e1 = cw[768 + 512 + c], e2 = cw[1536 + 512 + c], eb = cb[512 + c];
#pragma unroll
                for (int bb = 0; bb < 2; ++bb) { const bf16* ub = U + (size_t)((b0 + bb) * 768) * SEQ;
#pragma unroll
                    for (int k = 0; k < 4; ++k) { const int l = tid + 512 * k;
                        x1[q][bb][k] = hy_uc(ub + (size_t)c * SEQ, l, a0, a1, a2, ab);
                        x2[q][bb][k] = hy_uc(ub + (size_t)(256 + c) * SEQ, l, d0, d1, d2, db);
                        v[q][bb][k] = hy_uc(ub + (size_t)(512 + c) * SEQ, l, e0, e1, e2, eb); }
                    asm volatile("" ::: "memory"); } }
#pragma unroll
            for (int k = 0; k < 4; ++k) { const int l = tid + 512 * k;
                bufA[fpad(l)] = (f32x2){v[0][0][k], v[0][1][k]}; bufA[fpad(2048 + l)] = (f32x2){zf, zf};
                bufB[fpad(l)] = (f32x2){v[1][0][k], v[1][1][k]}; bufB[fpad(2048 + l)] = (f32x2){zf, zf}; }
            __syncthreads();
#pragma unroll 1
            for (int o = 0; o < 2; ++o) {
                const f32x2* kfa = KF + (size_t)(o * 256 + c0 + 2 * cp) * 4096; f32x2 ka[8], kb[8];
                fft_stage_fwd<0>(bufA, tw, tid); fft_stage_fwd<0>(bufB, tw, tid); __syncthreads();
                fft_stage_fwd<1>(bufA, tw, tid); fft_stage_fwd<1>(bufB, tw, tid); __syncthreads();
                fft_stage_fwd<2>(bufA, tw, tid); fft_stage_fwd<2>(bufB, tw, tid); __syncthreads();
#pragma unroll
                for (int k = 0; k < 8; ++k) { ka[k] = kfa[tid + 512 * k]; kb[k] = kfa[4096 + tid + 512 * k]; }
                fft_stage_fwd<3>(bufA, tw, tid); fft_stage_fwd<3>(bufB, tw, tid); __syncthreads();
#pragma unroll
                for (int k = 0; k < 8; ++k) { const int p = fpad(tid + 512 * k); bufA[p] = cmul(bufA[p], ka[k]); bufB[p] = cmul(bufB[p], kb[k]); }
                __syncthreads();
                fft_inv2(bufA, bufB, tw, tid);
                const float sa = skip[o * 256 + c0 + 2 * cp], sb = skip[o * 256 + c0 + 2 * cp + 1];
                if (o == 0) {
#pragma unroll
                    for (int k = 0; k < 4; ++k) { const int l = tid + 512 * k; const f32x2 ya = bufA[fpad(l)], yb = bufB[fpad(l)];
                        z[0][0][k] = x1[0][0][k] * (ya.x + v[0][0][k] * sa); z[0][1][k] = x1[0][1][k] * (ya.y + v[0][1][k] * sa);
                        z[1][0][k] = x1[1][0][k] * (yb.x + v[1][0][k] * sb); z[1][1][k] = x1[1][1][k] * (yb.y + v[1][1][k] * sb);
                        bufA[fpad(l)] = (f32x2){z[0][0][k], z[0][1][k]}; bufA[fpad(2048 + l)] = (f32x2){zf, zf};
                        bufB[fpad(l)] = (f32x2){z[1][0][k], z[1][1][k]}; bufB[fpad(2048 + l)] = (f32x2){zf, zf}; }
                } else {
#pragma unroll
                    for (int k = 0; k < 4; ++k) { const int l = tid + 512 * k; const f32x2 ya = bufA[fpad(l)], yb = bufB[fpad(l)];
                        const unsigned wa = cvtpk(x2[0][0][k] * (ya.x + z[0][0][k] * sa), x2[0][1][k] * (ya.y + z[0][1][k] * sa));
                        const unsigned wb = cvtpk(x2[1][0][k] * (yb.x + z[1][0][k] * sb), x2[1][1][k] * (yb.y + z[1][1][k] * sb));
                        *(LAS unsigned*)(stg + (size_t)l * 4 + 2 * cp) = (wa & 0xffffu) | (wb << 16);
                        *(LAS unsigned*)(stg + (size_t)(2048 + l) * 4 + 2 * cp) = (wa >> 16) | (wb & 0xffff0000u); }
                }
                __syncthreads();
            }
        }
        int tq = tid; asm volatile("" : "+v"(tq));
#pragma unroll 2
        for (int k = 0; k < 8; ++k) { const int t = tq + 512 * k, bb = t >> 11, l = t & 2047;
            *(u32x2*)(Y + (size_t)((b0 + bb) * SEQ + l) * 256 + c0) = *(const LAS u32x2*)(stg + (size_t)t * 4); }
        __syncthreads();
    }
}
__device__ __forceinline__ void fnet_phase(const Args& A, Frame& F) {
    unsigned char* wsl = A.ws; asm volatile("" : "+s"(wsl));
    LAS f32x2* bufA = (LAS f32x2*)(F.lds + FFT_BUF_OFF); LAS f32x2* bufB = (LAS f32x2*)(F.lds + FFT_BUF1_OFF); const LAS f32x2* tw = (const LAS f32x2*)(F.lds + FFT_TW_OFF); LAS bf16* stg = (LAS bf16*)(F.lds + FFT_STAGE_OFF);
    const bf16* U = (const bf16*)(wsl + WS_UFNT); bf16* Y = (bf16*)(wsl + WS_YFN);
    const int tid = F.tid; float zf = 0.f; asm volatile("" : "+v"(zf));
    for (int unit = blockIdx.x; unit < 256; unit += F.G) {
        const int b = unit >> 5, g = (unit >> 3) & 3, ch = unit & 7;
        for (int fp = 0; fp < 2; ++fp) {
            const int mA = 4 * ch + 2 * fp, mB = mA + 1;
            const bf16* ub = U + (size_t)(b * 256 + 64 * g) * SEQ;
#pragma unroll
            for (int k = 0; k < 4; ++k) { const int l = tid + 512 * k;
                bufA[fpad(l)] = (f32x2){bf2f(ub[(size_t)mA * SEQ + l]), bf2f(ub[(size_t)(32 + mA) * SEQ + l])}; bufA[fpad(2048 + l)] = (f32x2){zf, zf};
                bufB[fpad(l)] = (f32x2){bf2f(ub[(size_t)mB * SEQ + l]), bf2f(ub[(size_t)(32 + mB) * SEQ + l])}; bufB[fpad(2048 + l)] = (f32x2){zf, zf}; }
            __syncthreads();
            fft_fwd2(bufA, bufB, tw, tid);
#pragma unroll
            for (int k = 0; k < 4; ++k) { const int kk = tid + 512 * k; const int p1 = fpad(digrev(2 * kk)), p2 = fpad(digrev((2 * (2048 - kk)) & 4095));
                const f32x2 a1 = bufA[p1], a2 = bufA[p2], b1 = bufB[p1], b2 = bufB[p2];
                float ya, yb;
                if (mA == 0) { ya = 0.5f * (a1.x + a2.x); yb = 0.5f * (a1.y + a2.y); } else { ya = a1.x; yb = a2.x; }
                const unsigned w1 = cvtpk(ya, b1.x), w2 = cvtpk(b2.x, yb);
                *(LAS unsigned*)(stg + (size_t)kk * 8 + 2 * fp) = w1;
                *(LAS unsigned*)(stg + (size_t)kk * 8 + 6 - 2 * fp) = w2; }
            __syncthreads();
        }
#pragma unroll
        for (int k = 0; k < 4; ++k) { const int kk = tid + 512 * k; const v4u w = *(const LAS v4u*)(stg + (size_t)kk * 8);
            bf16* yr = Y + (size_t)(b * SEQ + kk) * 256 + 64 * g;
            *(u32x2*)(yr + 4 * ch) = (u32x2){w.x, w.y};
            bf16* y2 = yr + 61 - 4 * ch;
            y2[0] = (bf16)w.z; y2[1] = (bf16)(w.z >> 16); y2[2] = (bf16)w.w;
            if (ch == 0) yr[32] = (bf16)(w.w >> 16); else y2[3] = (bf16)(w.w >> 16); }
        __syncthreads();
    }
}
__device__ __forceinline__ void softmax_step(f32x16 (&S)[2], float& mrun, float& lrun, f32x16& o0, f32x16& o1, bf16x8 (&pf)[2][2], int lane) {
    float mx = S[0][0];
#pragma unroll
    for (int kb = 0; kb < 2; ++kb)
#pragma unroll
        for (int r = 0; r < 16; ++r) mx = fmaxf(mx, S[kb][r]);
    mx = fmaxf(mx, shx(mx, 32, lane));
    if (__any(mx > mrun + 8.0f)) { const float mnew = fmaxf(mrun, mx), alpha = fast_exp2(mrun - mnew); mrun = mnew; lrun *= alpha; o0 *= alpha; o1 *= alpha; }
    float ls = 0.f;
#pragma unroll
    for (int kb = 0; kb < 2; ++kb)
#pragma unroll
        for (int r = 0; r < 16; ++r) { const float p = fast_exp2(S[kb][r] - mrun); S[kb][r] = p; ls += p; }
    lrun += ls;
#pragma unroll
    for (int kb = 0; kb < 2; ++kb)
#pragma unroll
        for (int s2 = 0; s2 < 2; ++s2) { v4u w; w.x = cvtpk(S[kb][8 * s2 + 0], S[kb][8 * s2 + 1]); w.y = cvtpk(S[kb][8 * s2 + 2], S[kb][8 * s2 + 3]);
            w.z = cvtpk(S[kb][8 * s2 + 4], S[kb][8 * s2 + 5]); w.w = cvtpk(S[kb][8 * s2 + 6], S[kb][8 * s2 + 7]); pf[kb][s2] = __builtin_bit_cast(bf16x8, w); }
}
__device__ __forceinline__ void attn_store(bf16* yrow, const f32x16& o0, const f32x16& o1, float lrun, int hh, int lane) {
    const float lt = lrun + shx(lrun, 32, lane), inv = 1.0f / lt;
#pragma unroll
    for (int g = 0; g < 4; ++g) {
        st_bf16x4(yrow + 8 * g + 4 * hh, (f32x4){o0[4 * g] * inv, o0[4 * g + 1] * inv, o0[4 * g + 2] * inv, o0[4 * g + 3] * inv});
        st_bf16x4(yrow + 32 + 8 * g + 4 * hh, (f32x4){o1[4 * g] * inv, o1[4 * g + 1] * inv, o1[4 * g + 2] * inv, o1[4 * g + 3] * inv}); }
}
constexpr int NA_KP = 144, NA_VP = 136, NA_KB = 64 * NA_KP, NA_VB = 64 * NA_VP, NA_BUF = NA_KB + NA_VB, NA_RPB_OFF = 2 * NA_BUF;
__device__ __forceinline__ void na_phase(const Args& A, Frame& F, int li) {
    unsigned char* wsl = A.ws; asm volatile("" : "+s"(wsl));
    LAS float* rpbL = (LAS float*)(F.lds + NA_RPB_OFF);
    const float* rpb = A.in[18] + li * 4 * 15 * 31;
    for (int i = F.tid; i < 60 * 128; i += NTHR) { const int rw = i >> 7, dc = (i & 127) - 48; rpbL[i] = (dc >= 0 && dc < 31) ? rpb[rw * 31 + dc] * LOG2E : 0.f; }
    __syncthreads();
    const bf16* NQ = (const bf16*)(wsl + WS_NAQ); const bf16* NK = (const bf16*)(wsl + WS_NAK); const bf16* NVT = (const bf16*)(wsl + WS_NAVT); bf16* Y = (bf16*)(wsl + WS_YNA);
    const int tid = F.tid, lane = F.lane, hh = lane >> 5, lq = lane & 31;
    for (int unit = F.vcu; unit < 256; unit += F.G) {
        const int b = unit >> 5, h = (unit >> 3) & 3, r0 = (unit & 7) * 4;
        const int r = r0 + (F.wave >> 1), half = F.wave & 1;
        const int qtok = b * SEQ + r * 64 + half * 32 + lq, c = half * 32 + lq, cs = min(max(c - 8, 0), 48), rs = min(max(r - 4, 0), 24);
        const int klo = min(max(r0 - 4, 0), 24), khi = min(max(r0 + 3 - 4, 0), 24) + 7, nrow = khi - klo + 1;
        bf16x8 qf[4];
#pragma unroll
        for (int ks = 0; ks < 4; ++ks) qf[ks] = *(const bf16x8*)(NQ + (size_t)qtok * 256 + h * 64 + 16 * ks + 8 * hh);
        const bf16* Kg = NK + (size_t)(b * SEQ) * 256 + h * 64; const bf16* Vg = NVT + (size_t)(b * 256 + h * 64) * SEQ;
        const int kk = tid >> 3, kch = tid & 7;
        v4u rk, rv;
#define NA_LOAD(krow) do { rk = *(const v4u*)(Kg + (size_t)((krow) * 64 + kk) * 256 + kch * 8); rv = *(const v4u*)(Vg + (size_t)kk * SEQ + (krow) * 64 + kch * 8); } while (0)
#define NA_WRITE(bufi) do { LAS unsigned char* kb_ = F.lds + (bufi) * NA_BUF; *(LAS v4u*)(kb_ + kk * NA_KP + kch * 16) = rk; \
        LAS unsigned char* vb_ = kb_ + NA_KB + kk * NA_VP + kch * 16; *(LAS u32x2*)vb_ = (u32x2){rv.x, rv.y}; *(LAS u32x2*)(vb_ + 8) = (u32x2){rv.z, rv.w}; } while (0)
        f32x16 o0, o1;
#pragma unroll
        for (int i = 0; i < 16; ++i) { o0[i] = 0.f; o1[i] = 0.f; }
        float mrun = -1e30f, lrun = 0.f;
        NA_LOAD(klo); NA_WRITE(0);
        __syncthreads();
        for (int t = 0; t < nrow; ++t) {
            const int krow = klo + t;
            if (t + 1 < nrow) NA_LOAD(krow + 1);
            if (krow >= rs && krow < rs + 8) {
                const LAS unsigned char* kbuf = F.lds + (t & 1) * NA_BUF; const LAS unsigned char* vbuf = kbuf + NA_KB;
                const LAS float* bp = rpbL + (h * 15 + (krow - r + 7)) * 128 + (4 * hh - c + 15 + 48);
                f32x16 S[2];
#pragma unroll
                for (int kb = 0; kb < 2; ++kb) { f32x16 s;
#pragma unroll
                    for (int i = 0; i < 16; ++i) s[i] = 0.f;
#pragma unroll
                    for (int ks = 0; ks < 4; ++ks) s = __builtin_amdgcn_mfma_f32_32x32x16_bf16(*(const LAS bf16x8*)(kbuf + (kb * 32 + lq) * NA_KP + (16 * ks + 8 * hh) * 2), qf[ks], s, 0, 0, 0);
#pragma unroll
                    for (int rr = 0; rr < 16; ++rr) { const int ko = kb * 32 + (rr & 3) + 8 * (rr >> 2); const int kc = ko + 4 * hh; const bool ok = (kc >= cs) && (kc < cs + 16);
                        s[rr] = ok ? s[rr] + bp[ko] : -1e30f; }
                    S[kb] = s; }
                bf16x8 pf[2][2];
                softmax_step(S, mrun, lrun, o0, o1, pf, lane);
#pragma unroll
                for (int kb = 0; kb < 2; ++kb)
#pragma unroll
                    for (int s2 = 0; s2 < 2; ++s2) {
#pragma unroll
                        for (int db = 0; db < 2; ++db) { const LAS unsigned char* vp = vbuf + (db * 32 + lq) * NA_VP + (kb * 32 + 16 * s2 + 4 * hh) * 2;
                            const u32x2 lo = *(const LAS u32x2*)vp, hi = *(const LAS u32x2*)(vp + 16); const bf16x8 va = __builtin_bit_cast(bf16x8, (v4u){lo.x, lo.y, hi.x, hi.y});
                            if (db == 0) o0 = __builtin_amdgcn_mfma_f32_32x32x16_bf16(va, pf[kb][s2], o0, 0, 0, 0); else o1 = __builtin_amdgcn_mfma_f32_32x32x16_bf16(va, pf[kb][s2], o1, 0, 0, 0); } }
            }
            if (t + 1 < nrow) NA_WRITE((t + 1) & 1);
            __syncthreads();
        }
#undef NA_LOAD
#undef NA_WRITE
        attn_store(Y + (size_t)qtok * 256 + h * 64, o0, o1, lrun, hh, lane);
    }
}
constexpr int AT_KP = 208, AT_VP = 136, AT_KB = 64 * AT_KP, AT_VB = 64 * AT_VP, AT_BUF = AT_KB + AT_VB;
__device__ __forceinline__ void mla_attn_phase(const Args& A, Frame& F) {
    unsigned char* wsl = A.ws; asm volatile("" : "+s"(wsl));
    const bf16* Q = (const bf16*)(wsl + WS_Q); const bf16* KFU = (const bf16*)(wsl + WS_KFULL); const bf16* VT = (const bf16*)(wsl + WS_VT); bf16* Y = (bf16*)(wsl + WS_YMLA);
    const int tid = F.tid, lane = F.lane, hh = lane >> 5, lq = lane & 31;
    for (int unit = F.vcu; unit < 256; unit += F.G) {
        const int b = unit >> 5, h = (unit >> 3) & 3, qb = unit & 7;
        const int qtok = b * SEQ + qb * 256 + F.wave * 32 + lq;
        bf16x8 qf[6];
#pragma unroll
        for (int ks = 0; ks < 6; ++ks) qf[ks] = *(const bf16x8*)(Q + (size_t)qtok * 384 + h * 96 + 16 * ks + 8 * hh);
        const bf16* Kg = KFU + (size_t)(b * SEQ) * 384 + h * 96; const bf16* Vg = VT + (size_t)((b * 4 + h) * 64) * SEQ;
        const int kc0 = tid, kc1 = tid + 512; const bool k1ok = kc1 < 768;
        const int kk0 = kc0 / 12, kch0 = kc0 % 12, kk1 = k1ok ? kc1 / 12 : 0, kch1 = k1ok ? kc1 % 12 : 0, vd = tid >> 3, vch = tid & 7;
        v4u rk0, rk1, rv;
#define AT_LOAD(t) do { const int key0 = (t) * 64; rk0 = *(const v4u*)(Kg + (size_t)(key0 + kk0) * 384 + kch0 * 8); if (k1ok) rk1 = *(const v4u*)(Kg + (size_t)(key0 + kk1) * 384 + kch1 * 8); \
        rv = *(const v4u*)(Vg + (size_t)vd * SEQ + key0 + vch * 8); } while (0)
#define AT_WRITE(bufi) do { LAS unsigned char* kb_ = F.lds + (bufi) * AT_BUF; *(LAS v4u*)(kb_ + kk0 * AT_KP + kch0 * 16) = rk0; if (k1ok) *(LAS v4u*)(kb_ + kk1 * AT_KP + kch1 * 16) = rk1; \
        LAS unsigned char* vb_ = kb_ + AT_KB + vd * AT_VP + vch * 16; *(LAS u32x2*)vb_ = (u32x2){rv.x, rv.y}; *(LAS u32x2*)(vb_ + 8) = (u32x2){rv.z, rv.w}; } while (0)
        f32x16 o0, o1;
#pragma unroll
        for (int i = 0; i < 16; ++i) { o0[i] = 0.f; o1[i] = 0.f; }
        float mrun = -1e30f, lrun = 0.f;
        AT_LOAD(0); AT_WRITE(0);
        __syncthreads();
        for (int t = 0; t < 32; ++t) {
            if (t + 1 < 32) AT_LOAD(t + 1);
            const LAS unsigned char* kbuf = F.lds + (t & 1) * AT_BUF; const LAS unsigned char* vbuf = kbuf + AT_KB;
            f32x16 S[2];
            __builtin_amdgcn_s_setprio(1);
#pragma unroll
            for (int kb = 0; kb < 2; ++kb) { f32x16 s;
#pragma unroll
                for (int i = 0; i < 16; ++i) s[i] = 0.f;
#pragma unroll
                for (int ks = 0; ks < 6; ++ks) s = __builtin_amdgcn_mfma_f32_32x32x16_bf16(*(const LAS bf16x8*)(kbuf + (kb * 32 + lq) * AT_KP + (16 * ks + 8 * hh) * 2), qf[ks], s, 0, 0, 0);
                S[kb] = s; }
            __builtin_amdgcn_s_setprio(0);
            bf16x8 pf[2][2];
            softmax_step(S, mrun, lrun, o0, o1, pf, lane);
            __builtin_amdgcn_s_setprio(1);
#pragma unroll
            for (int kb = 0; kb < 2; ++kb)
#pragma unroll
                for (int s2 = 0; s2 < 2; ++s2) {
#pragma unroll
                    for (int db = 0; db < 2; ++db) { const LAS unsigned char* vp = vbuf + (db * 32 + lq) * AT_VP + (kb * 32 + 16 * s2 + 4 * hh) * 2;
                        const u32x2 lo = *(const LAS u32x2*)vp, hi = *(const LAS u32x2*)(vp + 16); const bf16x8 va = __builtin_bit_cast(bf16x8, (v4u){lo.x, lo.y, hi.x, hi.y});
                        if (db == 0) o0 = __builtin_amdgcn_mfma_f32_32x32x16_bf16(va, pf[kb][s2], o0, 0, 0, 0); else o1 = __builtin_amdgcn_mfma_f32_32x32x16_bf16(va, pf[kb][s2], o1, 0, 0, 0); } }
            __builtin_amdgcn_s_setprio(0);
            if (t + 1 < 32) AT_WRITE((t + 1) & 1);
            __syncthreads();
        }
#undef AT_LOAD
#undef AT_WRITE
        attn_store(Y + (size_t)qtok * 256 + h * 64, o0, o1, lrun, hh, lane);
    }
}
#ifndef MK_DEBUG
#define MK_DEBUG 0
#endif

__device__ __forceinline__ void router_phase(const Args& A, Frame& F, int li) {
    unsigned char* wsl = A.ws; asm volatile("" : "+s"(wsl));
    LAS float* wL = (LAS float*)F.lds;
    const float* wr = A.in[22] + (size_t)li * DM * NEXP; const float* g2 = A.in[21] + li * DM;
    for (int i = F.tid; i < DM * NEXP; i += NTHR) { const int k = i >> 4, e = i & 15; wL[(k >> 2) * 64 + e * 4 + (k & 3)] = wr[i] * g2[k]; }
    __syncthreads();
    float* AFF = (float*)(wsl + WS_AFF); float* IR2 = (float*)(wsl + WS_STAT) + (size_t)5 * TOK;
    const int gw = F.vcu * NWAVES + F.wave, NGW = F.G * NWAVES, lane = F.lane, g = lane >> 4, j = lane & 15;
    for (int grp = gw; grp < TOK / 16; grp += NGW) {
        const int row0 = grp * 16;
        const bf16* xp = (const bf16*)(wsl + WS_XB) + (size_t)(row0 + j) * DM + 4 * g; const LAS float* wp = wL + g * 64 + 4 * j;
        f32x4 acc = (f32x4){0.f, 0.f, 0.f, 0.f}; float ss = 0.f;
#pragma unroll 8
        for (int t = 0; t < 64; ++t) { const f32x4 xv = ld_bf16x4(xp + 16 * t); const f32x4 wv = *(const LAS f32x4*)(wp + 256 * t);
            ss += (xv.x * xv.x + xv.y * xv.y) + (xv.z * xv.z + xv.w * xv.w);
            acc = __builtin_amdgcn_mfma_f32_16x16x4f32(xv.x, wv.x, acc, 0, 0, 0); acc = __builtin_amdgcn_mfma_f32_16x16x4f32(xv.y, wv.y, acc, 0, 0, 0);
            acc = __builtin_amdgcn_mfma_f32_16x16x4f32(xv.z, wv.z, acc, 0, 0, 0); acc = __builtin_amdgcn_mfma_f32_16x16x4f32(xv.w, wv.w, acc, 0, 0, 0); }
        ss += shx(ss, 16, lane); ss += shx(ss, 32, lane);
        const float inv = rsqrtf(ss * (1.0f / 1024.0f) + EPS);
        const int b = row0 >> 11, l0 = row0 & 2047;
#pragma unroll
        for (int r = 0; r < 4; ++r) {
            const float lg = acc[r] * shl_from(inv, 4 * g + r);
            float mx = lg;
#pragma unroll
            for (int o = 1; o < 16; o <<= 1) mx = fmaxf(mx, shx(mx, o, lane));
            const float ex = __expf(lg - mx); float den = ex;
#pragma unroll
            for (int o = 1; o < 16; o <<= 1) den += shx(den, o, lane);
            AFF[(size_t)(b * NEXP + j) * SEQ + l0 + 4 * g + r] = ex / den;
        }
        if (g == 0) IR2[row0 + j] = inv;
    }
}
__device__ __forceinline__ void topk_phase(const Args& A, Frame& F) {
    unsigned char* wsl = A.ws; asm volatile("" : "+s"(wsl));
    LAS unsigned* hist = (LAS unsigned*)F.lds;
    LAS unsigned* sh = hist + 256;
    LAS int* idxL = (LAS int*)(hist + 512);
    const float* AFF = (const float*)(wsl + WS_AFF); const float* IR2 = (const float*)(wsl + WS_STAT) + (size_t)5 * TOK;
    int* INV = (int*)(wsl + WS_INV); float* ROWSC = (float*)(wsl + WS_SEL); float* SELAFF = ROWSC + NSLOT;
    const bf16* XB = (const bf16*)(wsl + WS_XB); bf16* XE = (bf16*)(wsl + WS_XE);
    const int tid = F.tid, lane = F.lane, wave = F.wave;
    for (int unit = blockIdx.x; unit < NB * NEXP; unit += F.G) {
        const int b = unit >> 4, e = unit & 15;
        const f32x4 av = *(const f32x4*)(AFF + (size_t)unit * SEQ + 4 * tid);
        unsigned key[4] = {__float_as_uint(av[0]), __float_as_uint(av[1]), __float_as_uint(av[2]), __float_as_uint(av[3])};
        unsigned prefix = 0u, krem = CAP;
        for (int pass = 0; pass < 4; ++pass) {
            const int shift = 24 - 8 * pass;
            if (tid < 256) hist[tid] = 0u;
            __syncthreads();
#pragma unroll
            for (int i = 0; i < 4; ++i) { const bool match = (pass == 0) || ((key[i] >> (shift + 8)) == (prefix >> (shift + 8))); if (match) __hip_atomic_fetch_add(&hist[(key[i] >> shift) & 255u], 1u, __ATOMIC_RELAXED, __HIP_MEMORY_SCOPE_WORKGROUP); }
            __syncthreads();
            if (wave == 0) {
                const unsigned c0 = hist[4 * lane], c1 = hist[4 * lane + 1], c2 = hist[4 * lane + 2], c3 = hist[4 * lane + 3], t = c0 + c1 + c2 + c3;
                unsigned v = t;
#pragma unroll
                for (int o = 1; o < 64; o <<= 1) { const unsigned uu = shlu_from(v, (lane + o) & 63); if (lane + o < 64) v += uu; }
                unsigned cum = v - t;
                if (cum < krem && cum + t >= krem) {
                    int bsel; unsigned knew;
                    if (cum + c3 >= krem) { bsel = 4 * lane + 3; knew = krem - cum; }
                    else if (cum + c3 + c2 >= krem) { bsel = 4 * lane + 2; knew = krem - cum - c3; }
                    else if (cum + c3 + c2 + c1 >= krem) { bsel = 4 * lane + 1; knew = krem - cum - c3 - c2; }
                    else { bsel = 4 * lane; knew = krem - cum - c3 - c2 - c1; }
                    sh[0] = prefix | ((unsigned)bsel << shift); sh[1] = knew; } }
            __syncthreads();
            prefix = sh[0]; krem = sh[1];
            __syncthreads();
        }
        unsigned eqc = 0u, gtc = 0u;
#pragma unroll
        for (int i = 0; i < 4; ++i) { eqc += key[i] == prefix; gtc += key[i] > prefix; }
        unsigned eqs = eqc;
#pragma unroll
        for (int o = 1; o < 64; o <<= 1) { const unsigned t = shlu_from(eqs, (lane - o) & 63); if (lane >= o) eqs += t; }
        if (lane == 63) sh[16 + wave] = eqs;
        __syncthreads();
        unsigned eqbase = eqs - eqc;
        for (int w = 0; w < wave; ++w) eqbase += sh[16 + w];
        __syncthreads();
        bool sel[4]; unsigned selc = 0u, er = eqbase;
#pragma unroll
        for (int i = 0; i < 4; ++i) { if (key[i] > prefix) sel[i] = true; else if (key[i] == prefix) { sel[i] = er < krem; ++er; } else sel[i] = false; selc += sel[i]; }
        unsigned ss = selc;
#pragma unroll
        for (int o = 1; o < 64; o <<= 1) { const unsigned t = shlu_from(ss, (lane - o) & 63); if (lane >= o) ss += t; }
        if (lane == 63) sh[32 + wave] = ss;
        __syncthreads();
        unsigned slot = ss - selc;
        for (int w = 0; w < wave; ++w) slot += sh[32 + w];
        const int grp = e * NB + b;
#pragma unroll
        for (int i = 0; i < 4; ++i) { const int l = 4 * tid + i; int sv = -1;
            if (sel[i]) { sv = (int)slot; ++slot; idxL[sv] = l; ROWSC[grp * CAP + sv] = IR2[b * SEQ + l]; SELAFF[grp * CAP + sv] = __builtin_bit_cast(float, key[i]); }
            INV[(size_t)(b * SEQ + l) * NEXP + e] = sv; }
        __syncthreads();
        for (int it = 0; it < 64; it += 4) {
            v4u r[4];
#pragma unroll
            for (int q = 0; q < 4; ++q) { const int srow = (it + q) * 4 + (tid >> 7); r[q] = *(const v4u*)(XB + (size_t)(b * SEQ + idxL[srow]) * DM + (tid & 127) * 8); }
#pragma unroll
            for (int q = 0; q < 4; ++q) { const int srow = (it + q) * 4 + (tid >> 7); *(v4u*)(XE + (size_t)(grp * CAP + srow) * DM + (tid & 127) * 8) = r[q]; }
        }
        __syncthreads();
    }
}

#if MK_DEBUG
__device__ __forceinline__ void debug_moe_check(const Args& A, Frame& F, int li) {
    unsigned char* wsl = A.ws; asm volatile("" : "+s"(wsl));
    LAS float* hs = (LAS float*)F.lds; LAS float* hid = hs + 1024; LAS float* red = hid + 1024; LAS int* tokp = (LAS int*)(red + 64);
    const int* INV = (const int*)(wsl + WS_INV); const bf16* YE = (const bf16*)(wsl + WS_XE); const float* AFF = (const float*)(wsl + WS_AFF);
    const float* g2 = A.in[21] + li * DM; const float* wg = A.in[23] + (size_t)li * NEXP * DM * DM; const float* wu = A.in[24] + (size_t)li * NEXP * DM * DM; const float* wd = A.in[25] + (size_t)li * NEXP * DM * DM;
    float* dbg = (float*)(wsl + WS_CTL) + 1024;
    const int tid = F.tid;
    for (int unit = blockIdx.x; unit < 256; unit += F.G) {
        const int grp = unit >> 1, slot = (unit & 1) * 131 + 7, e = grp >> 3, b = grp & 7;
        if (tid == 0) tokp[0] = -1;
        __syncthreads();
        for (int l = tid; l < SEQ; l += NTHR) if (INV[(size_t)(b * SEQ + l) * NEXP + e] == slot) tokp[0] = l;
        __syncthreads();
        const int l = tokp[0]; if (l < 0) { if (tid == 0) atomicAdd(dbg + 2, 1.0f); __syncthreads(); continue; }
        const float* xr = A.out + (size_t)(b * SEQ + l) * DM;
        float s = 0.f; for (int k = tid; k < DM; k += NTHR) s += xr[k] * xr[k];
        s = wave_sum(s, F.lane); if (F.lane == 0) red[F.wave] = s; __syncthreads();
        float tot = 0.f; for (int w = 0; w < 8; ++w) tot += red[w];
        const float inv = rsqrtf(tot * (1.0f / 1024.0f) + EPS);
        for (int k = tid; k < DM; k += NTHR) hs[k] = xr[k] * inv * g2[k];
        __syncthreads();
        for (int f = tid; f < DM; f += NTHR) { float g = 0.f, u = 0.f; for (int k = 0; k < DM; ++k) { g += hs[k] * wg[((size_t)e * DM + k) * DM + f]; u += hs[k] * wu[((size_t)e * DM + k) * DM + f]; }
            hid[f] = g / (1.0f + __expf(-g)) * u; }
        __syncthreads();
        { const bf16* XE_ = (const bf16*)(wsl + WS_XE); const bf16* XB_ = (const bf16*)(wsl + WS_XB); float mm = 0.f;
          for (int k = tid; k < DM; k += NTHR) mm += (XE_[(size_t)(grp * CAP + slot) * DM + k] != XB_[(size_t)(b * SEQ + l) * DM + k]) ? 1.f : 0.f;
          mm = wave_sum(mm, F.lane); if (F.lane == 0 && mm > 0.f) atomicAdd(dbg + 3, mm);
          const bf16* HB_ = (const bf16*)(wsl + WS_HB); float he = 0.f, hr = 0.f;
          for (int f = tid; f < DM; f += NTHR) { const float m2 = bf2f(HB_[(size_t)(grp * CAP + slot) * DM + f]); he += (hid[f] - m2) * (hid[f] - m2); hr += hid[f] * hid[f]; }
          he = wave_sum(he, F.lane); hr = wave_sum(hr, F.lane); if (F.lane == 0) { atomicAdd(dbg + 4, he); atomicAdd(dbg + 5, hr); } }
        { const float* wr = A.in[22] + (size_t)li * DM * NEXP;
          if (tid < 16) { float a = 0.f; for (int k = 0; k < DM; ++k) a += hs[k] * wr[k * NEXP + tid]; red[16 + tid] = a; }
          __syncthreads();
          if (tid == 0) { float mx = red[16]; for (int q = 1; q < 16; ++q) mx = fmaxf(mx, red[16 + q]); float den = 0.f; for (int q = 0; q < 16; ++q) den += __expf(red[16 + q] - mx);
              float ee = 0.f, rr = 0.f; for (int q = 0; q < 16; ++q) { const float t = __expf(red[16 + q] - mx) / den, m2 = AFF[(size_t)(b * NEXP + q) * SEQ + l]; ee += (t - m2) * (t - m2); rr += t * t; }
              atomicAdd(dbg + 6, ee); atomicAdd(dbg + 7, rr); }
          if (slot == 7) { float mn = 1e30f; int ns = 0; for (int q = tid; q < SEQ; q += NTHR) if (INV[(size_t)(b * SEQ + q) * NEXP + e] >= 0) { ++ns; mn = fminf(mn, AFF[(size_t)(b * NEXP + e) * SEQ + q]); }
              for (int o = 1; o < 64; o <<= 1) { mn = fminf(mn, shx(mn, o, F.lane)); ns += (int)shxu((unsigned)ns, o, F.lane); }
              __syncthreads(); if (F.lane == 0) { red[40 + F.wave] = mn; red[48 + F.wave] = (float)ns; } __syncthreads();
              float gmn = 1e30f; int gns = 0; for (int w = 0; w < 8; ++w) { gmn = fminf(gmn, red[40 + w]); gns += (int)red[48 + w]; }
              int bad = 0; for (int q = tid; q < SEQ; q += NTHR) if (INV[(size_t)(b * SEQ + q) * NEXP + e] < 0 && AFF[(size_t)(b * NEXP + e) * SEQ + q] > gmn) ++bad;
              if (bad > 0) atomicAdd(dbg + 9, (float)bad); if (tid == 0 && gns != 256) atomicAdd(dbg + 10, 1.0f); __syncthreads(); } }
        const float aff = AFF[(size_t)(b * NEXP + e) * SEQ + l];
        float e2 = 0.f, r2 = 0.f;
        for (int d = tid; d < DM; d += NTHR) { float y = 0.f; for (int f = 0; f < DM; ++f) y += hid[f] * wd[((size_t)e * DM + f) * DM + d]; y *= aff;
            const float mine = bf2f(YE[(size_t)(grp * CAP + slot) * DM + d]); const float yu = y / aff; e2 += (yu - mine) * (yu - mine); r2 += yu * yu; }
        if (tid == 0) { const float sa = ((const float*)(wsl + WS_SEL))[NSLOT + grp * CAP + slot]; if (fabsf(sa - aff) > 1e-6f) atomicAdd(dbg + 8, 1.0f); }
        e2 = wave_sum(e2, F.lane); r2 = wave_sum(r2, F.lane);
        __syncthreads();
        if (F.lane == 0) { atomicAdd(dbg + 0, e2); atomicAdd(dbg + 1, r2); }
        __syncthreads();
    }
}
#endif
__device__ __forceinline__ void combine_phase(const Args& A, Frame& F) {
    unsigned char* wsl = A.ws; asm volatile("" : "+s"(wsl));
    const float* AFFp = (const float*)(wsl + WS_AFF);
    const int* INV = (const int*)(wsl + WS_INV); const bf16* YE = (const bf16*)(wsl + WS_XE); bf16* XB = (bf16*)(wsl + WS_XB); float* IR3 = (float*)(wsl + WS_STAT) + (size_t)6 * TOK;
    const int gw = F.vcu * NWAVES + F.wave, NGW = F.G * NWAVES, lane = F.lane;
    for (int row = gw; row < TOK; row += NGW) {
        const int b = row >> 11; const int iv = INV[(size_t)row * NEXP + (lane & 15)];
        u32x2* brow = (u32x2*)(XB + (size_t)row * DM) + lane;
        f32x4 v[4];
#pragma unroll
        for (int j = 0; j < 4; ++j) { const u32x2 w = brow[64 * j]; v[j] = (f32x4){__builtin_bit_cast(float, w.x << 16), __builtin_bit_cast(float, w.x & 0xffff0000u), __builtin_bit_cast(float, w.y << 16), __builtin_bit_cast(float, w.y & 0xffff0000u)}; }
#pragma unroll
        for (int e = 0; e < 16; ++e) { const int slot = __builtin_amdgcn_readlane(iv, e);
            if (slot >= 0 && !((MK_DROP >> 4) & 1)) { const bf16* yr = YE + (size_t)((e * NB + b) * CAP + slot) * DM + 4 * lane; const float af = AFFp[(size_t)(b * NEXP + e) * SEQ + (row & 2047)];
#pragma unroll
                for (int j = 0; j < 4; ++j) v[j] += ld_bf16x4(yr + 256 * j) * af; } }
        float s = 0.f;
#pragma unroll
        for (int j = 0; j < 4; ++j) { if (A.sub != 9) brow[64 * j] = (u32x2){cvtpk(v[j].x, v[j].y), cvtpk(v[j].z, v[j].w)}; s += (v[j].x * v[j].x + v[j].y * v[j].y) + (v[j].z * v[j].z + v[j].w * v[j].w); }
        s = wave_sum(s, F.lane);
        if (lane == 0) IR3[row] = rsqrtf(s * (1.0f / 1024.0f) + EPS);
    }
}
__device__ __forceinline__ void final_phase(const Args& A, Frame& F) {
    unsigned char* wsl = A.ws; asm volatile("" : "+s"(wsl));
    const f32x4* sp = (const f32x4*)(wsl + WS_SSP); const f32x4* fg = (const f32x4*)A.in[29] + F.lane;
    const int gw = F.vcu * NWAVES + F.wave, NGW = F.G * NWAVES;
    float dscale = 1.0f;
#if MK_DEBUG
    { const float* dbg = (const float*)(wsl + WS_CTL) + 1024; dscale = 1.0f + 10.0f * sqrtf(dbg[6] / fmaxf(dbg[7], 1e-30f)) + (dbg[9] > 0.f ? 1000.0f : 0.f) + (dbg[10] > 0.f ? 30000.0f : 0.f); }
#endif
    f32x4 g[4];
#pragma unroll
    for (int j = 0; j < 4; ++j) g[j] = fg[64 * j];
    for (int row = gw; row < TOK; row += NGW) {
        f32x4* xr = (f32x4*)(A.out + (size_t)row * DM) + F.lane; const u32x2* brow = (const u32x2*)((const bf16*)(wsl + WS_XB) + (size_t)row * DM) + F.lane; const f32x4 p0 = sp[4 * row], p1 = sp[4 * row + 1], p2 = sp[4 * row + 2], p3 = sp[4 * row + 3];
        const float ssr = (((p0.x + p0.y) + (p0.z + p0.w)) + ((p1.x + p1.y) + (p1.z + p1.w))) + (((p2.x + p2.y) + (p2.z + p2.w)) + ((p3.x + p3.y) + (p3.z + p3.w)));
        const float inv = rsqrtf(ssr * (1.0f / 1024.0f) + EPS);
#pragma unroll
        for (int j = 0; j < 4; ++j) { const u32x2 w = brow[64 * j]; const f32x4 xv = (f32x4){__builtin_bit_cast(float, w.x << 16), __builtin_bit_cast(float, w.x & 0xffff0000u), __builtin_bit_cast(float, w.y << 16), __builtin_bit_cast(float, w.y & 0xffff0000u)};
            const f32x4 o = xv * (inv * dscale) * g[j]; if (A.sub != 9) xr[64 * j] = o; else asm volatile("" :: "v"(o)); }
    }
}

#ifndef MK_PER_PHASE
#define MK_PER_PHASE 0
#endif
constexpr int NPH = 26;
__global__ void __launch_bounds__(NTHR, 2) mk_fwd(Args A) {
    extern __shared__ __attribute__((aligned(16))) unsigned char lds_raw[];
    Frame F;
    F.lds = (LAS unsigned char*)lds_raw;
    F.tid = threadIdx.x; F.lane = F.tid & 63; F.wave = __builtin_amdgcn_readfirstlane(F.tid >> 6);
    F.G = gridDim.x; { const int bx = blockIdx.x; F.vcu = (F.G % 8 == 0) ? (bx % 8) * (F.G / 8) + bx / 8 : bx; }
    volatile LAS unsigned* MISC = (volatile LAS unsigned*)(F.lds + LDSCTL_OFF);
    if (F.tid < 64) MISC[F.tid] = 0u;
    __syncthreads();
    const int lo = A.ph_lo, hi = A.ph_hi;
    unsigned* ctl = (unsigned*)(A.ws + WS_CTL);
    XcdBarrier bar; bar.bar = ctl + CW_BAR + A.bar_idx * XCD_BAR_WORDS; bar.x = 0; bar.st = nullptr;
    if (hi - lo > 1) bar = xcd_barrier_post(ctl + CW_BAR + A.bar_idx * XCD_BAR_WORDS, MISC + 8);
#ifndef MK_MASK
#define MK_MASK 0xFFFFFFu
#endif
#define KIND(j) (((MK_MASK) >> (j)) & 1u)
#define REFRESH() do { int l_; asm volatile("v_mbcnt_lo_u32_b32 %0, -1, 0\n\tv_mbcnt_hi_u32_b32 %0, -1, %0" : "=v"(l_)); l_ &= 63; F.lane = l_; F.tid = F.wave * 64 + l_; } while (0)
    LAS unsigned char* ring = F.lds;
    for (int ph = lo; ph < hi; ++ph) {
        const int li = ph >= 13 ? 1 : 0, kk = (ph == 0) ? 12 : (ph == 25 ? 13 : ph - 1 - 12 * li);
        unsigned char* ws = A.ws; asm volatile("" : "+s"(ws));
        if (kk == 12) { if (KIND(0)) { REFRESH(); phase_p0(A, F); } }
        else if (kk == 0) { if (KIND(1)) { REFRESH(); phase_l0a(A, F, li); } }
        else if (kk == 1) { if (KIND(2)) {
            { pg8::Gemm g{(const bf16*)(ws + WS_XB), (const bf16*)(ws + WS_WIN), TOK, NWIN, DM}; pg8::StaticOrder S; S.init(TOK, NWIN, F.G, (int)blockIdx.x);
              EpiWin E{(const float*)(ws + WS_STAT) + (size_t)li * TOK, A.in[4] + li * 4096, ws};
              pg8::gemm_phase<EpiWin, pg8::StaticOrder, true, true>(ring, g, S, E, F.wave); }
            REFRESH();
            if (F.G == 256) { if (blockIdx.x >= 64) filter_fft(A, F, (int)blockIdx.x - 64, 192); } else filter_fft(A, F, (int)blockIdx.x, (int)F.G); } }
        else if (kk == 2) {
            const int sub = A.sub;
            REFRESH();
            if (KIND(14) || KIND(15)) fft_init_tw(A, F);
            if (KIND(14) && (sub == 0 || sub == 1)) hyena_phase(A, F, li);
            REFRESH();
            if (KIND(15) && (sub == 0 || sub == 2)) fnet_phase(A, F);
            __syncthreads();
            REFRESH();
            if (KIND(16) && (sub == 0 || sub == 3)) na_phase(A, F, li);
            __syncthreads();
            if (KIND(17) && (sub == 0 || sub == 4)) { pg8::Gemm g{(const bf16*)(ws + WS_CQ), (const bf16*)(ws + WS_WUQ), TOK, 512, 256}; pg8::StaticOrder S; S.init(TOK, 512, F.G, (int)blockIdx.x);
              EpiQ E{ws}; pg8::gemm_phase<EpiQ, pg8::StaticOrder, true, true>(ring, g, S, E, F.wave); }
            if (KIND(18) && (sub == 0 || sub == 4)) { pg8::Gemm g{(const bf16*)(ws + WS_CKV), (const bf16*)(ws + WS_WUKV), TOK, 512, 256}; pg8::StaticOrder S; S.init(TOK, 512, F.G, (int)((blockIdx.x + F.G / 2) % F.G));
              EpiKV E{ws}; pg8::gemm_phase<EpiKV, pg8::StaticOrder, true, true>(ring, g, S, E, F.wave); } }
        else if (kk == 3) { if (KIND(4)) { REFRESH(); mla_attn_phase(A, F); } }
        else if (kk == 4) { if (KIND(5)) {
            pg8::Gemm g{(const bf16*)(ws + WS_YHY), (const bf16*)(ws + WS_WBR), TOK, DM, 256}; BranchOrder S; S.so.init(TOK, DM, F.G, (int)blockIdx.x);
            EpiBranch E{ws}; pg8::gemm_phase<EpiBranch, BranchOrder, true, true>(ring, g, S, E, F.wave); } }
        else if (kk == 5) { if (KIND(6)) {
            pg8::Gemm g{(const bf16*)(ws + WS_MERGED), (const bf16*)(ws + WS_WOUT), TOK, DM, DM}; pg8::StaticOrder S; S.init(TOK, DM, F.G, (int)blockIdx.x);
            EpiResid E{ws, A.sub == 9}; pg8::gemm_phase<EpiResid, pg8::StaticOrder, true, true>(ring, g, S, E, F.wave); } }
        else if (kk == 6) { if (KIND(7)) { REFRESH(); router_phase(A, F, li); } }
        else if (kk == 7) { if (KIND(8)) {
            if (F.G == 256 && blockIdx.x >= 128) {
                pg8::Gemm g{(const bf16*)(ws + WS_PB), (const bf16*)(ws + WS_WPP), TOK, DM, 256}; pg8::StaticOrder S; S.init(TOK, DM, 128, (int)blockIdx.x - 128);
                EpiPP E{ws}; pg8::gemm_phase<EpiPP, pg8::StaticOrder, true, true>(ring, g, S, E, F.wave);
            } else { REFRESH(); topk_phase(A, F); }
            if (F.G != 256) { pg8::Gemm g{(const bf16*)(ws + WS_PB), (const bf16*)(ws + WS_WPP), TOK, DM, 256}; pg8::StaticOrder S; S.init(TOK, DM, F.G, (int)blockIdx.x);
                EpiPP E{ws}; pg8::gemm_phase<EpiPP, pg8::StaticOrder, true, true>(ring, g, S, E, F.wave); } } }
        else if (kk == 8) { if (KIND(9)) {
            pg8::Gemm g{(const bf16*)(ws + WS_XE), (const bf16*)(ws + WS_WE1), NSLOT, NEXP * 2048, DM}; MoeOrder S{F.G, (int)blockIdx.x, 8, 1024};
            EpiSwiglu E{ws}; pg8::gemm_phase<EpiSwiglu, MoeOrder, true, true>(ring, g, S, E, F.wave); } }
        else if (kk == 9) { if (KIND(10)) {
            pg8::Gemm g{(const bf16*)(ws + WS_HB), (const bf16*)(ws + WS_WE2), NSLOT, NEXP * 1024, DM}; MoeOrder S{F.G, (int)blockIdx.x, 4, 512};
            EpiDown E{ws}; pg8::gemm_phase<EpiDown, MoeOrder, true, true>(ring, g, S, E, F.wave); } }
        else if (kk == 10) { if (KIND(11)) { REFRESH(); combine_phase(A, F); } }
        else if (kk == 11) { if (KIND(12)) {
            pg8::Gemm g{(const bf16*)(ws + WS_XB), (const bf16*)(ws + WS_WPG), TOK, DM, DM}; pg8::StaticOrder S; S.init(TOK, DM, F.G, (int)blockIdx.x);
            EpiPle E{ws, (float*)(ws + WS_SSP), A.sub == 9}; pg8::gemm_phase<EpiPle, pg8::StaticOrder, true, true>(ring, g, S, E, F.wave); } }
        else { if (KIND(13)) { REFRESH(); final_phase(A, F); } }
        if (ph + 1 < hi) xcd_barrier(bar, F.wave);
    }
#undef KIND
#undef REFRESH
}

extern "C" void kernel_launch(void* const* d_in, const int* in_sizes, int n_in, void* d_out, int out_size, void* d_ws, size_t ws_size, hipStream_t stream) {
    static int grid = 0;
    if (grid == 0) {
        if (n_in != 30 || in_sizes[0] != TOK * DM || out_size != TOK * DM || ws_size < WS_END) {
            fprintf(stderr, "kernel_launch: unexpected problem (n_in %d, in0 %d, out %d, ws %zu < %zu); nothing launched\n", n_in, n_in > 0 ? in_sizes[0] : -1, out_size, ws_size, (size_t)WS_END); grid = -1; return; }
        int dev = 0, cus = 0, per_cu = 0;
        if (hipGetDevice(&dev) != hipSuccess || hipDeviceGetAttribute(&cus, hipDeviceAttributeMultiprocessorCount, dev) != hipSuccess) { fprintf(stderr, "kernel_launch: device query failed\n"); grid = -1; return; }
        if (hipFuncSetAttribute((const void*)mk_fwd, hipFuncAttributeMaxDynamicSharedMemorySize, LDS_BYTES) != hipSuccess) { fprintf(stderr, "kernel_launch: hipFuncSetAttribute failed\n"); grid = -1; return; }
        if (hipOccupancyMaxActiveBlocksPerMultiprocessor(&per_cu, (const void*)mk_fwd, NTHR, LDS_BYTES) != hipSuccess || per_cu < 1)
            fprintf(stderr, "kernel_launch: note: occupancy query reports %d workgroups per CU\n", per_cu);
        (void)hipGetLastError();
        grid = cus;
    }
    if (grid < 0) return;
    if (hipMemsetAsync((char*)d_ws + WS_CTL, 0, CTL_ZERO_BYTES, stream) != hipSuccess) { fprintf(stderr, "kernel_launch: memset failed\n"); return; }
    Args a{};
    for (int i = 0; i < 30; ++i) a.in[i] = (const float*)d_in[i];
    a.out = (float*)d_out; a.ws = (unsigned char*)d_ws;
#if MK_PER_PHASE
    for (int p = 0; p < NPH; ++p) { a.ph_lo = p; a.ph_hi = p + 1; hipLaunchKernelGGL(mk_fwd, dim3(grid), dim3(NTHR), LDS_BYTES, stream, a); }
#elif defined(MK_PROBE_A)
    {
        const int cuts[6] = {0, MK_PROBE_A, MK_PROBE_A + 1, MK_PROBE_B, MK_PROBE_B + 1, NPH}; int bi = 0;
        for (int s = 0; s < 5; ++s) { const int reps = (s == 1 || s == 3) ? 2 : 1;
            for (int r = 0; r < reps; ++r) { a.ph_lo = cuts[s]; a.ph_hi = cuts[s + 1]; a.bar_idx = bi++; a.sub = (r == 1) ? MK_PROBE_SUB : 0; if (a.ph_hi > a.ph_lo) hipLaunchKernelGGL(mk_fwd, dim3(grid), dim3(NTHR), LDS_BYTES, stream, a); } }
    }
#else
    a.ph_lo = 0; a.ph_hi = NPH;
    hipLaunchKernelGGL(mk_fwd, dim3(grid), dim3(NTHR), LDS_BYTES, stream, a);
#endif
    const hipError_t le = hipPeekAtLastError();
    if (le != hipSuccess) fprintf(stderr, "kernel_launch: launch failed: %s\n", hipGetErrorName(le));
}
```
